# Optimizing an MI355X kernel written in HIP

```python
import jax, jax.numpy as jnp
from jax import lax
import numpy as np


D_MODEL = 2048
BATCH = 4
SEQ = 2048
DEPTH = 2

HEAD_DIM = 128
ROPE_THETA = 500000.0
ROPE_DIM = HEAD_DIM // 4
NORM_EPS = 1e-6
NEG_INF = -1e30

NSA_HEADS = 8
NSA_KV_HEADS = 2
NSA_CMP_LEN = 32
NSA_CMP_STRIDE = 16
NSA_CMP_HIDDEN = 256
NSA_SEL_BLOCK = 64
NSA_SEL_TOPN = 16
NSA_WINDOW = 512
NSA_Q_CHUNK = 64
NSA_FORCE_BONUS = 1e4

DIL_GROUPS = ((128, 1), (512, 4), (2048, 16))
DIL_HEADS_PER_GROUP = 4
DIL_HEADS = DIL_HEADS_PER_GROUP * len(DIL_GROUPS)
DIL_Q_CHUNK = 128

MOBA_HEADS = 8
MOBA_BLOCK = 256
MOBA_TOPK = 3
MOBA_Q_CHUNK = 32

BAND_BLOCK = 128
D_FF = 4 * D_MODEL

A_Q = NSA_HEADS * HEAD_DIM
A_KV = NSA_KV_HEADS * HEAD_DIM
A_G = 3 * NSA_HEADS
B_QKV = DIL_HEADS * HEAD_DIM
C_QKV = MOBA_HEADS * HEAD_DIM
A_OUT = NSA_HEADS * HEAD_DIM
B_OUT = DIL_HEADS_PER_GROUP * HEAD_DIM
C_OUT = MOBA_HEADS * HEAD_DIM
IN_SPLIT_SIZES = (A_Q, A_KV, A_KV, A_KV, A_KV, A_KV, A_KV, A_G,
                  B_QKV, B_QKV, B_QKV, C_QKV, C_QKV, C_QKV,
                  D_MODEL, D_MODEL, D_MODEL)
IN_WIDTH = sum(IN_SPLIT_SIZES)

kernel_name = "nsa_dilated_moba_gated_hybrid"


def rms_norm(x, g):
    xf = x.astype(jnp.float32)
    y = xf * lax.rsqrt(jnp.mean(xf * xf, axis=-1, keepdims=True) + NORM_EPS)
    return (y * g.astype(jnp.float32)).astype(x.dtype)


def rope_tables(seq):
    inv = ROPE_THETA ** (-jnp.arange(0, ROPE_DIM, 2, dtype=jnp.float32) / ROPE_DIM)
    ang = jnp.arange(seq, dtype=jnp.float32)[:, None] * inv[None, :]
    return jnp.cos(ang), jnp.sin(ang)


def apply_partial_rope(x, cos, sin):
    half = ROPE_DIM // 2
    xf = x[..., :ROPE_DIM].astype(jnp.float32)
    x1, x2 = xf[..., :half], xf[..., half:]
    c = cos[None, :, None, :]
    s = sin[None, :, None, :]
    rot = jnp.concatenate([x1 * c - x2 * s, x2 * c + x1 * s], axis=-1).astype(x.dtype)
    return jnp.concatenate([rot, x[..., ROPE_DIM:]], axis=-1)


def masked_softmax(scores, mask):
    s = jnp.where(mask, scores, NEG_INF)
    m = jnp.max(s, axis=-1, keepdims=True)
    e = jnp.where(mask, jnp.exp(s - m), 0.0)
    den = jnp.maximum(jnp.sum(e, axis=-1, keepdims=True), 1e-30)
    return e / den, (m + jnp.log(den))[..., 0]


def banded_causal_attention(q, k, v, window):
    B, S, H, dh = q.shape
    G = k.shape[2]
    R = H // G
    nb = S // BAND_BLOCK
    span = window + BAND_BLOCK
    kp = jnp.pad(k, ((0, 0), (window, 0), (0, 0), (0, 0)))
    vp = jnp.pad(v, ((0, 0), (window, 0), (0, 0), (0, 0)))
    idx = np.arange(nb)[:, None] * BAND_BLOCK + np.arange(span)[None, :]
    kb = kp[:, idx]
    vb = vp[:, idx]
    qb = q.reshape(B, nb, BAND_BLOCK, G, R, dh)
    s = jnp.einsum('bitgrd,bisgd->bigrts', qb, kb, preferred_element_type=jnp.float32) * dh ** -0.5
    tpos = np.arange(nb)[:, None] * BAND_BLOCK + np.arange(BAND_BLOCK)[None, :]
    kpos = idx - window
    mask = ((kpos[:, None, :] <= tpos[:, :, None]) & (kpos[:, None, :] > tpos[:, :, None] - window)
            & (kpos[:, None, :] >= 0))
    p, _ = masked_softmax(s, mask[None, :, None, None])
    o = jnp.einsum('bigrts,bisgd->bitgrd', p.astype(vb.dtype), vb)
    return o.reshape(B, S, H, dh)


def nsa_compress(kv, pe, w1, w2):
    S = kv.shape[1]
    M = (S - NSA_CMP_LEN) // NSA_CMP_STRIDE + 1
    idx = np.arange(M)[:, None] * NSA_CMP_STRIDE + np.arange(NSA_CMP_LEN)[None, :]
    blocks = kv[:, idx] + pe[None, None, :, None, :]
    hid = jax.nn.gelu(jnp.einsum('bmlgd,ldf->bmgf', blocks, w1))
    return jnp.einsum('bmgf,fd->bmgd', hid, w2)


def cmp_to_sel_overlap(seq):
    M = (seq - NSA_CMP_LEN) // NSA_CMP_STRIDE + 1
    NB = seq // NSA_SEL_BLOCK
    cs = np.arange(M)[:, None] * NSA_CMP_STRIDE
    bs = np.arange(NB)[None, :] * NSA_SEL_BLOCK
    ov = np.clip(np.minimum(cs + NSA_CMP_LEN, bs + NSA_SEL_BLOCK) - np.maximum(cs, bs), 0, None) / NSA_CMP_LEN
    return jnp.asarray(ov, dtype=jnp.float32)


def nsa_mixer(q, k_cmp, v_cmp, k_sel, v_sel, k_win, v_win, gates,
              pe_k, w1_k, w2_k, pe_v, w1_v, w2_v, cos, sin):
    B, S, H, dh = q.shape
    G = NSA_KV_HEADS
    R = H // G
    scale = dh ** -0.5
    t_pos = jnp.arange(S)

    kc = nsa_compress(k_cmp, pe_k, w1_k, w2_k)
    vc = nsa_compress(v_cmp, pe_v, w1_v, w2_v)
    M = kc.shape[1]
    qg = q.reshape(B, S, G, R, dh)
    s_c = jnp.einsum('btgrd,bmgd->btgrm', qg, kc, preferred_element_type=jnp.float32) * scale
    cmp_end = jnp.arange(M) * NSA_CMP_STRIDE + NSA_CMP_LEN - 1
    mask_c = (cmp_end[None, :] <= t_pos[:, None])[None, :, None, None, :]
    p_c, _ = masked_softmax(s_c, mask_c)
    o_cmp = jnp.einsum('btgrm,bmgd->btgrd', p_c.astype(vc.dtype), vc).reshape(B, S, H, dh)

    NB = S // NSA_SEL_BLOCK
    imp = jnp.einsum('btgrm,mj->btgj', p_c, cmp_to_sel_overlap(S))
    blk = jnp.arange(NB)
    q_blk = t_pos // NSA_SEL_BLOCK
    causal_blk = blk[None, :] <= q_blk[:, None]
    forced = (blk[None, :] == 0) | (blk[None, :] == q_blk[:, None]) | (blk[None, :] == q_blk[:, None] - 1)
    bonus = jnp.where(forced, NSA_FORCE_BONUS, 0.0)
    score = jnp.where(causal_blk[None, :, None, :], imp + bonus[None, :, None, :], NEG_INF)
    n_sel = min(NSA_SEL_TOPN, NB)
    top_s, top_i = lax.top_k(score, n_sel)
    top_ok = top_s > NEG_INF * 0.5

    qr = apply_partial_rope(q, cos, sin)
    ks = apply_partial_rope(k_sel, cos, sin).reshape(B, NB, NSA_SEL_BLOCK, G, dh).transpose(0, 3, 1, 2, 4)
    vs = v_sel.reshape(B, NB, NSA_SEL_BLOCK, G, dh).transpose(0, 3, 1, 2, 4)
    bi = jnp.arange(B)[:, None, None, None]
    gi = jnp.arange(G)[None, None, :, None]
    Qc = NSA_Q_CHUNK
    nkey = n_sel * NSA_SEL_BLOCK

    def sel_chunk(c):
        t0 = c * Qc
        tc = t0 + jnp.arange(Qc)
        qc = lax.dynamic_slice_in_dim(qr, t0, Qc, axis=1).reshape(B, Qc, G, R, dh)
        ic = lax.dynamic_slice_in_dim(top_i, t0, Qc, axis=1)
        okc = lax.dynamic_slice_in_dim(top_ok, t0, Qc, axis=1)
        kg = ks[bi, gi, ic]
        vg = vs[bi, gi, ic]
        s = jnp.einsum('btgrd,btgnld->btgrnl', qc, kg, preferred_element_type=jnp.float32) * scale
        kpos = ic[..., None] * NSA_SEL_BLOCK + jnp.arange(NSA_SEL_BLOCK)
        mask = (kpos <= tc[None, :, None, None, None]) & okc[..., None]
        p, _ = masked_softmax(s.reshape(B, Qc, G, R, nkey), mask.reshape(B, Qc, G, 1, nkey))
        o = jnp.einsum('btgrk,btgkd->btgrd', p.astype(vg.dtype), vg.reshape(B, Qc, G, nkey, dh))
        return o.reshape(B, Qc, H, dh)

    o_sel = lax.map(sel_chunk, jnp.arange(S // Qc))
    o_sel = o_sel.transpose(1, 0, 2, 3, 4).reshape(B, S, H, dh)

    o_win = banded_causal_attention(qr, apply_partial_rope(k_win, cos, sin), v_win, NSA_WINDOW)

    return gates[..., 0:1] * o_cmp + gates[..., 1:2] * o_sel + gates[..., 2:3] * o_win


def dilated_group_attention(q, k, v, window, dilation):
    B, S, Hg, dh = q.shape
    nk = window // dilation + 1
    Qc = DIL_Q_CHUNK
    offs = dilation * jnp.arange(nk)
    scale = dh ** -0.5

    def chunk(c):
        t = c * Qc + jnp.arange(Qc)
        kidx = t[:, None] - offs[None, :]
        ok = kidx >= 0
        kidx = jnp.maximum(kidx, 0)
        qc = lax.dynamic_slice_in_dim(q, c * Qc, Qc, axis=1)
        kg = k[:, kidx]
        vg = v[:, kidx]
        s = jnp.einsum('bthd,btnhd->bthn', qc, kg, preferred_element_type=jnp.float32) * scale
        p, lse = masked_softmax(s, ok[None, :, None, :])
        o = jnp.einsum('bthn,btnhd->bthd', p.astype(vg.dtype), vg)
        return o, lse

    o, lse = lax.map(chunk, jnp.arange(S // Qc))
    o = o.transpose(1, 0, 2, 3, 4).reshape(B, S, Hg, dh)
    lse = lse.transpose(1, 0, 2, 3).reshape(B, S, Hg)
    return o, lse


def dilated_mixer(q, k, v):
    outs, lses = [], []
    for g, (w, r) in enumerate(DIL_GROUPS):
        sl = slice(g * DIL_HEADS_PER_GROUP, (g + 1) * DIL_HEADS_PER_GROUP)
        o, l = dilated_group_attention(q[:, :, sl], k[:, :, sl], v[:, :, sl], w, r)
        outs.append(o)
        lses.append(l)
    alpha = jax.nn.softmax(jnp.stack(lses, axis=0), axis=0)
    o_all = jnp.stack(outs, axis=0)
    return jnp.sum(alpha[..., None].astype(o_all.dtype) * o_all, axis=0)


def moba_mixer(q, k, v):
    B, S, H, dh = q.shape
    L = MOBA_BLOCK
    nbk = -(-S // L)
    pad = nbk * L - S
    kb = jnp.pad(k, ((0, 0), (0, pad), (0, 0), (0, 0))).reshape(B, nbk, L, H, dh)
    vb = jnp.pad(v, ((0, 0), (0, pad), (0, 0), (0, 0))).reshape(B, nbk, L, H, dh)
    kmean = jnp.mean(kb.astype(jnp.float32), axis=2)
    gate = jnp.einsum('bthd,bjhd->bthj', q.astype(jnp.float32), kmean)
    t_pos = jnp.arange(S)
    past = jnp.arange(nbk)[None, :] < (t_pos // L)[:, None]
    gate = jnp.where(past[None, :, None, :], gate, NEG_INF)
    ktop = min(MOBA_TOPK, nbk)
    top_s, top_i = lax.top_k(gate, ktop)
    top_ok = top_s > NEG_INF * 0.5
    kbt = kb.transpose(0, 3, 1, 2, 4)
    vbt = vb.transpose(0, 3, 1, 2, 4)
    bi = jnp.arange(B)[:, None, None, None]
    hi = jnp.arange(H)[None, None, :, None]
    Qc = MOBA_Q_CHUNK
    nsel = ktop * L
    scale = dh ** -0.5

    def chunk(c):
        t0 = c * Qc
        tc = t0 + jnp.arange(Qc)
        qc = lax.dynamic_slice_in_dim(q, t0, Qc, axis=1)
        ic = lax.dynamic_slice_in_dim(top_i, t0, Qc, axis=1)
        okc = lax.dynamic_slice_in_dim(top_ok, t0, Qc, axis=1)
        kg = kbt[bi, hi, ic].reshape(B, Qc, H, nsel, dh)
        vg = vbt[bi, hi, ic].reshape(B, Qc, H, nsel, dh)
        s_sel = jnp.einsum('bthd,bthkd->bthk', qc, kg, preferred_element_type=jnp.float32) * scale
        m_sel = jnp.broadcast_to(okc[..., None], (B, Qc, H, ktop, L)).reshape(B, Qc, H, nsel)
        own = t0 // L
        k_own = lax.dynamic_index_in_dim(kb, own, axis=1, keepdims=False)
        v_own = lax.dynamic_index_in_dim(vb, own, axis=1, keepdims=False)
        s_own = jnp.einsum('bthd,blhd->bthl', qc, k_own, preferred_element_type=jnp.float32) * scale
        m_own = (own * L + jnp.arange(L))[None, :] <= tc[:, None]
        m_own = jnp.broadcast_to(m_own[None, :, None, :], (B, Qc, H, L))
        p, _ = masked_softmax(jnp.concatenate([s_sel, s_own], axis=-1),
                              jnp.concatenate([m_sel, m_own], axis=-1))
        p = p.astype(v.dtype)
        return (jnp.einsum('bthk,bthkd->bthd', p[..., :nsel], vg)
                + jnp.einsum('bthl,blhd->bthd', p[..., nsel:], v_own))

    o = lax.map(chunk, jnp.arange(S // Qc))
    return o.transpose(1, 0, 2, 3, 4).reshape(B, S, H, dh)


def hybrid_layer(x, cos, sin, attn_g, w_in, pe_k, w1_k, w2_k, pe_v, w1_v, w2_v,
                 w_br_a, w_br_b, w_br_c, w_o, mlp_g, w_mlp_in, w_mlp_out):
    B, S, D = x.shape
    h = rms_norm(x, attn_g)
    proj = jnp.einsum('bsd,dn->bsn', h, w_in)
    split_points = np.cumsum(IN_SPLIT_SIZES)[:-1].tolist()
    (a_q, a_kc, a_vc, a_ks, a_vs, a_kw, a_vw, a_g,
     b_q, b_k, b_v, c_q, c_k, c_v, m_a, m_b, m_c) = jnp.split(proj, split_points, axis=-1)

    def heads(t, n):
        return t.reshape(B, S, n, HEAD_DIM)

    a_gates = jax.nn.sigmoid(a_g.astype(jnp.float32)).reshape(B, S, NSA_HEADS, 3).astype(x.dtype)
    o_a = nsa_mixer(heads(a_q, NSA_HEADS),
                    heads(a_kc, NSA_KV_HEADS), heads(a_vc, NSA_KV_HEADS),
                    heads(a_ks, NSA_KV_HEADS), heads(a_vs, NSA_KV_HEADS),
                    heads(a_kw, NSA_KV_HEADS), heads(a_vw, NSA_KV_HEADS),
                    a_gates, pe_k, w1_k, w2_k, pe_v, w1_v, w2_v, cos, sin)
    o_b = dilated_mixer(apply_partial_rope(heads(b_q, DIL_HEADS), cos, sin),
                        apply_partial_rope(heads(b_k, DIL_HEADS), cos, sin),
                        heads(b_v, DIL_HEADS))
    o_c = moba_mixer(apply_partial_rope(heads(c_q, MOBA_HEADS), cos, sin),
                     apply_partial_rope(heads(c_k, MOBA_HEADS), cos, sin),
                     heads(c_v, MOBA_HEADS))

    y_a = jnp.einsum('bsk,kd->bsd', o_a.reshape(B, S, A_OUT), w_br_a)
    y_b = jnp.einsum('bsk,kd->bsd', o_b.reshape(B, S, B_OUT), w_br_b)
    y_c = jnp.einsum('bsk,kd->bsd', o_c.reshape(B, S, C_OUT), w_br_c)
    merged = jax.nn.sigmoid(m_a) * y_a + jax.nn.sigmoid(m_b) * y_b + jax.nn.sigmoid(m_c) * y_c
    x = x + jnp.einsum('bsd,de->bse', merged, w_o)

    h2 = rms_norm(x, mlp_g)
    u = jnp.square(jax.nn.relu(jnp.einsum('bsd,df->bsf', h2, w_mlp_in)))
    return x + jnp.einsum('bsf,fd->bsd', u, w_mlp_out)


def setup_inputs(seed: int = 0) -> dict:
    key = jax.random.key(seed)
    ks = jax.random.split(key, 18)
    f32 = jnp.float32
    D = D_MODEL

    def nrm(k, shape, scale):
        return jax.random.normal(k, shape, f32) * scale

    return {
        "x": nrm(ks[0], (BATCH, SEQ, D), 1.0),
        "attn_norm_g": 1.0 + nrm(ks[1], (DEPTH, D), 0.02),
        "w_in": nrm(ks[2], (DEPTH, D, IN_WIDTH), D ** -0.5),
        "cmp_pe_k": nrm(ks[3], (DEPTH, NSA_CMP_LEN, HEAD_DIM), 0.02),
        "cmp_w1_k": nrm(ks[4], (DEPTH, NSA_CMP_LEN, HEAD_DIM, NSA_CMP_HIDDEN), (NSA_CMP_LEN * HEAD_DIM) ** -0.5),
        "cmp_w2_k": nrm(ks[5], (DEPTH, NSA_CMP_HIDDEN, HEAD_DIM), NSA_CMP_HIDDEN ** -0.5),
        "cmp_pe_v": nrm(ks[6], (DEPTH, NSA_CMP_LEN, HEAD_DIM), 0.02),
        "cmp_w1_v": nrm(ks[7], (DEPTH, NSA_CMP_LEN, HEAD_DIM, NSA_CMP_HIDDEN), (NSA_CMP_LEN * HEAD_DIM) ** -0.5),
        "cmp_w2_v": nrm(ks[8], (DEPTH, NSA_CMP_HIDDEN, HEAD_DIM), NSA_CMP_HIDDEN ** -0.5),
        "w_br_a": nrm(ks[9], (DEPTH, A_OUT, D), A_OUT ** -0.5),
        "w_br_b": nrm(ks[10], (DEPTH, B_OUT, D), B_OUT ** -0.5),
        "w_br_c": nrm(ks[11], (DEPTH, C_OUT, D), C_OUT ** -0.5),
        "w_o": nrm(ks[12], (DEPTH, D, D), D ** -0.5),
        "mlp_norm_g": 1.0 + nrm(ks[13], (DEPTH, D), 0.02),
        "w_mlp_in": nrm(ks[14], (DEPTH, D, D_FF), D ** -0.5),
        "w_mlp_out": nrm(ks[15], (DEPTH, D_FF, D), D_FF ** -0.5),
        "final_norm_g": 1.0 + nrm(ks[16], (D,), 0.02),
    }


def reference(x, attn_norm_g, w_in, cmp_pe_k, cmp_w1_k, cmp_w2_k, cmp_pe_v, cmp_w1_v, cmp_w2_v,
              w_br_a, w_br_b, w_br_c, w_o, mlp_norm_g, w_mlp_in, w_mlp_out, final_norm_g):
    cos, sin = rope_tables(x.shape[1])
    for l in range(DEPTH):
        x = hybrid_layer(x, cos, sin, attn_norm_g[l], w_in[l],
                         cmp_pe_k[l], cmp_w1_k[l], cmp_w2_k[l], cmp_pe_v[l], cmp_w1_v[l], cmp_w2_v[l],
                         w_br_a[l], w_br_b[l], w_br_c[l], w_o[l],
                         mlp_norm_g[l], w_mlp_in[l], w_mlp_out[l])
    return rms_norm(x, final_norm_g)
```

```cpp
#include <hip/hip_runtime.h>
#include <hip/hip_cooperative_groups.h>
#include <cstdio>
#include <cstdint>
namespace cg = cooperative_groups;
namespace pg8 {
#define PG8_LAS __attribute__((address_space(3)))
typedef unsigned short bf16_t;
typedef short bf16x8 __attribute__((ext_vector_type(8)));
typedef float f32x4 __attribute__((ext_vector_type(4)));
typedef unsigned u32x4 __attribute__((ext_vector_type(4)));
constexpr int BM = 256, BK = 64, HALF = 128, HTB = HALF * BK * 2  , STAGE_BYTES = 8 * HTB, NXCD = 8, WGM = 8;

__host__ __device__ __forceinline__ int lds_byte(int r, int c) { const int st = (r >> 4) * 2 + (c >> 5), rr = r & 15, cc = c & 31, ob = rr * 64 + cc * 2; return st * 1024 + (ob ^ (((ob >> 9) & 1) << 5)); }
__host__ __device__ __forceinline__ void stage_rc(int b, int& R, int& C) { const int st = b / 1024, sb = b % 1024, swz = sb ^ (((sb >> 9) & 1) << 5); R = (st >> 1) * 16 + swz / 64; C = (st & 1) * 32 + (swz % 64) / 2; }
__host__ __device__ __forceinline__ int perm32(int rho) { const int n = rho >> 4, i = rho & 15; return 8 * (i >> 2) + 4 * n + (i & 3); }

struct Unit { int pm, pn; };
struct Gemm { const bf16_t* A; const bf16_t* Bt; int M, N, K; };

struct StaticOrder {
    int nM, nN, nwg, G, c;
    __host__ __device__ void init(int M, int N, int G_, int c_) { nM = M / BM; nN = N / BM; nwg = nM * nN; G = G_; c = c_; }
    __host__ __device__ __forceinline__ bool next(int i, Unit& u) const {
        const long L = (long)i * G + c; if (L >= nwg) return false;
        int wgid = (int)L; { const int q = nwg / NXCD, r = nwg % NXCD, xcd = wgid % NXCD, off = wgid / NXCD; wgid = (xcd < r ? xcd * (q + 1) : r * (q + 1) + (xcd - r) * q) + off; }
        const int nig = WGM * nN, gid = wgid / nig, fm = gid * WGM, gsz = (nM - fm) < WGM ? (nM - fm) : WGM;
        u.pm = fm + ((wgid % nig) % gsz); u.pn = (wgid % nig) / gsz; return true;
    }
    __device__ __forceinline__ void a_ready(const Unit&) const {}
    __device__ __forceinline__ void done(const Unit&) const {}
};


__device__ __forceinline__ unsigned cvt_pk_bf16(float lo, float hi) { unsigned r; asm volatile("v_cvt_pk_bf16_f32 %0, %1, %2" : "=v"(r) : "v"(lo), "v"(hi)); return r; }
typedef unsigned u32x2 __attribute__((ext_vector_type(2)));
__device__ __forceinline__ float bf_lo(unsigned w) { return __uint_as_float(w << 16); }
__device__ __forceinline__ float bf_hi(unsigned w) { return __uint_as_float(w & 0xffff0000u); }
__device__ __forceinline__ float sigmoidf_(float x) { return 1.0f / (1.0f + __expf(-x)); }
__device__ __forceinline__ void store8bf(bf16_t* p, f32x4 v0, f32x4 v1) {
    u32x4 w; w.x = cvt_pk_bf16(v0[0], v0[1]); w.y = cvt_pk_bf16(v0[2], v0[3]); w.z = cvt_pk_bf16(v1[0], v1[1]); w.w = cvt_pk_bf16(v1[2], v1[3]);
    *(u32x4*)p = w;
}

constexpr int IP_PITCH = 16640, GM_PITCH = 6400, NHM = 80;
__device__ __forceinline__ float row_rscale(const float* ssp, int row) {
    const f32x4* pp = (const f32x4*)(ssp + (size_t)row * 32);
    float s = 0.f;
#pragma unroll
    for (int i = 0; i < 8; ++i) { const f32x4 v = pp[i]; s += (v[0] + v[1]) + (v[2] + v[3]); }
    return rsqrtf(s * (1.0f / 2048.0f) + 1e-6f);
}
struct EpiInProj {
    static constexpr bool HAS_MID = false; static constexpr int T1 = -1, T2 = -1; static constexpr bool PERM = true, AFTER_DRAIN = false;
    bf16_t* HM; bf16_t* QR; bf16_t* GM; const float* rope; const PG8_LAS float* rst;
    __device__ __forceinline__ bool rope_seg(int cb) const { return cb < 1024 || (cb >= 1536 && cb < 1792) || (cb >= 2048 && cb < 2304) || (cb >= 2560 && cb < 5632) || (cb >= 7168 && cb < 9216); }
    __device__ __forceinline__ void operator()(const f32x4 (&acc)[2][2][4][2], const Unit& u, int wr, int wc, int fr, int fq) const {
        const int row0 = u.pm * BM + wr * 64 + fr, cin = wc * 32 + 8 * fq;
        const int cb0 = u.pn * BM, cb1 = cb0 + HALF;
        const bool rot0 = rope_seg(cb0) && (wc == 0), rot1 = rope_seg(cb1) && (wc == 0);
        const f32x4 k0 = (fq & 1) ? (f32x4){0.00022507907903927653f, 9.911730936901935e-05f, 4.364795279280289e-05f, 1.9221100684944863e-05f} : (f32x4){0.15915494309189535f, 0.0700865215877985f, 0.03086376340470123f, 0.013591370636193905f};
        const f32x4 k1 = (fq & 1) ? (f32x4){8.464330808241401e-06f, 3.727408601915352e-06f, 1.6414262627950345e-06f, 7.228293068832865e-07f} : (f32x4){0.005985185712713705f, 0.002635675898667414f, 0.001160663641240061f, 0.0005111175045375439f};
        const float sg = (fq < 2) ? -1.0f : 1.0f;
#pragma unroll
        for (int ai = 0; ai < 2; ++ai)
#pragma unroll
            for (int m = 0; m < 4; ++m) {
                const int row = row0 + ai * HALF + m * 16, b = row >> 11, t = row & 2047;
                const float rs = rst[wr * 64 + fr + ai * HALF + m * 16];
                f32x4 c0, c1, s0, s1;
                if (rot0 || rot1) {
                    const float tf = (float)t;
#pragma unroll
                    for (int e = 0; e < 4; ++e) {
                        const float r0 = __builtin_amdgcn_fractf(tf * k0[e]), r1 = __builtin_amdgcn_fractf(tf * k1[e]);
                        c0[e] = __builtin_amdgcn_cosf(r0); s0[e] = __builtin_amdgcn_sinf(r0) * sg; c1[e] = __builtin_amdgcn_cosf(r1); s1[e] = __builtin_amdgcn_sinf(r1) * sg;
                    }
                }
#pragma unroll
                for (int bj = 0; bj < 2; ++bj) {
                    const int cb = bj ? cb1 : cb0;
                    const bool isq = cb < 1024, ishm = cb < 10240, rot = bj ? rot1 : rot0;
                    const int hidx = cb >> 7;
                    f32x4 v0 = acc[ai][bj][m][0] * rs, v1 = acc[ai][bj][m][1] * rs;
                    bf16_t* hp = HM + ((((size_t)(b * NHM + hidx)) * 2048 + t) << 7) + cin;
                    if (isq) store8bf(hp, v0, v1);
                    if (rot) {
                        f32x4 p0, p1;
#pragma unroll
                        for (int e = 0; e < 4; ++e) { p0[e] = __shfl_xor(v0[e], 32); p1[e] = __shfl_xor(v1[e], 32); }
                        v0 = v0 * c0 + p0 * s0; v1 = v1 * c1 + p1 * s1;
                    }
                    bf16_t* dst = isq ? (QR + ((((size_t)(b * 8 + hidx)) * 2048 + t) << 7) + cin) : (ishm ? hp : (GM + (size_t)row * GM_PITCH + (cb - 10240) + cin));
                    store8bf(dst, v0, v1);
                }
            }
    }
};
template <int MODE> struct EpiBranch {
    static constexpr bool HAS_MID = false; static constexpr int T1 = -1, T2 = -1; static constexpr bool PERM = false, AFTER_DRAIN = false;
    const bf16_t* GM; int gcol; float* TMP; bf16_t* MG;
    __device__ __forceinline__ void operator()(const f32x4 (&acc)[2][2][4][2], const Unit& u, int wr, int wc, int fr, int fq) const {
        const int row0 = u.pm * BM + wr * 64 + fr, col0 = u.pn * BM + wc * 32 + 4 * fq;
#pragma unroll
        for (int ai = 0; ai < 2; ++ai)
#pragma unroll
            for (int m = 0; m < 4; ++m) {
                const int row = row0 + ai * HALF + m * 16;
#pragma unroll
                for (int bj = 0; bj < 2; ++bj)
#pragma unroll
                    for (int n = 0; n < 2; ++n) {
                        const int col = col0 + bj * HALF + n * 16;
                        const u32x2 mr = *(const u32x2*)(GM + (size_t)row * GM_PITCH + gcol + col);
                        f32x4 sg; sg[0] = sigmoidf_(bf_lo(mr.x)); sg[1] = sigmoidf_(bf_hi(mr.x)); sg[2] = sigmoidf_(bf_lo(mr.y)); sg[3] = sigmoidf_(bf_hi(mr.y));
                        f32x4 val = acc[ai][bj][m][n] * sg;
                        float* tp = TMP + (size_t)row * 2048 + col;
                        if (MODE == 0) { *(f32x4*)tp = val; }
                        else if (MODE == 1) { *(f32x4*)tp = *(const f32x4*)tp + val; }
                        else { val = val + *(const f32x4*)tp; u32x2 w; w.x = cvt_pk_bf16(val[0], val[1]); w.y = cvt_pk_bf16(val[2], val[3]); *(u32x2*)(MG + (size_t)row * 2048 + col) = w; }
                    }
                asm volatile("" ::: "memory");
            }
    }
};
struct EpiBranchF {
    static constexpr bool HAS_MID = true; static constexpr int T1 = 16, T2 = 24; static constexpr bool PERM = false, AFTER_DRAIN = false;
    const bf16_t* GM; bf16_t* MG;
    __device__ __forceinline__ void mid(f32x4 (&acc)[2][2][4][2], const Unit& u, int t, int wr, int wc, int fr, int fq) const {
        const int gx = (t == T1) ? 0 : 2048;
        int fr_ = fr, fq_ = fq; asm volatile("" : "+v"(fr_), "+v"(fq_));
        const int row0 = u.pm * BM + wr * 64 + fr_, col0 = u.pn * BM + wc * 32 + 4 * fq_;
#pragma unroll
        for (int ai = 0; ai < 2; ++ai)
#pragma unroll
            for (int m = 0; m < 4; ++m) {
                const bf16_t* gp = GM + (size_t)(row0 + ai * HALF + m * 16) * GM_PITCH + gx + col0;
#pragma unroll
                for (int bj = 0; bj < 2; ++bj)
#pragma unroll
                    for (int n = 0; n < 2; ++n) {
                        const u32x2 mx = *(const u32x2*)(gp + bj * HALF + n * 16), my = *(const u32x2*)(gp + 2048 + bj * HALF + n * 16);
                        f32x4 r;
                        r[0] = (1.0f + __expf(-bf_lo(my.x))) * __builtin_amdgcn_rcpf(1.0f + __expf(-bf_lo(mx.x))); r[1] = (1.0f + __expf(-bf_hi(my.x))) * __builtin_amdgcn_rcpf(1.0f + __expf(-bf_hi(mx.x)));
                        r[2] = (1.0f + __expf(-bf_lo(my.y))) * __builtin_amdgcn_rcpf(1.0f + __expf(-bf_lo(mx.y))); r[3] = (1.0f + __expf(-bf_hi(my.y))) * __builtin_amdgcn_rcpf(1.0f + __expf(-bf_hi(mx.y)));
                        acc[ai][bj][m][n] = acc[ai][bj][m][n] * r;
                        if (n == 1) asm volatile("" ::: "memory");
                    }
            }
    }
    __device__ __forceinline__ void operator()(const f32x4 (&acc)[2][2][4][2], const Unit& u, int wr, int wc, int fr, int fq) const {
        const int row0 = u.pm * BM + wr * 64 + fr, col0 = u.pn * BM + wc * 32 + 4 * fq;
#pragma unroll
        for (int ai = 0; ai < 2; ++ai)
#pragma unroll
            for (int m = 0; m < 4; ++m) {
                const int row = row0 + ai * HALF + m * 16;
#pragma unroll
                for (int bj = 0; bj < 2; ++bj)
#pragma unroll
                    for (int n = 0; n < 2; ++n) {
                        const int col = col0 + bj * HALF + n * 16;
                        const u32x2 mr = *(const u32x2*)(GM + (size_t)row * GM_PITCH + 4096 + col);
                        f32x4 sg; sg[0] = sigmoidf_(bf_lo(mr.x)); sg[1] = sigmoidf_(bf_hi(mr.x)); sg[2] = sigmoidf_(bf_lo(mr.y)); sg[3] = sigmoidf_(bf_hi(mr.y));
                        const f32x4 val = acc[ai][bj][m][n] * sg;
                        u32x2 w; w.x = cvt_pk_bf16(val[0], val[1]); w.y = cvt_pk_bf16(val[2], val[3]); *(u32x2*)(MG + (size_t)row * 2048 + col) = w;
                    }
                if (m & 1) asm volatile("" ::: "memory");
            }
    }
};
struct EpiResid {
    static constexpr bool HAS_MID = false; static constexpr int T1 = -1, T2 = -1; static constexpr bool PERM = false, AFTER_DRAIN = false;
    const float* base; float* out; bf16_t* xb; float* ssp;
    __device__ __forceinline__ void operator()(const f32x4 (&acc)[2][2][4][2], const Unit& u, int wr, int wc, int fr, int fq) const {
        const int row0 = u.pm * BM + wr * 64 + fr, col0 = u.pn * BM + wc * 32 + 4 * fq;
#pragma unroll
        for (int ai = 0; ai < 2; ++ai) {
            f32x4 bs[4][2][2];
#pragma unroll
            for (int m = 0; m < 4; ++m)
#pragma unroll
                for (int bj = 0; bj < 2; ++bj)
#pragma unroll
                    for (int n = 0; n < 2; ++n) bs[m][bj][n] = *(const f32x4*)(base + (size_t)(row0 + ai * HALF + m * 16) * 2048 + col0 + bj * HALF + n * 16);
            asm volatile("" ::: "memory");
#pragma unroll
            for (int m = 0; m < 4; ++m) {
                const int row = row0 + ai * HALF + m * 16;
                const size_t off = (size_t)row * 2048 + col0;
                float ss = 0.f;
#pragma unroll
                for (int bj = 0; bj < 2; ++bj)
#pragma unroll
                    for (int n = 0; n < 2; ++n) {
                        const size_t o2 = off + bj * HALF + n * 16; const f32x4 v = bs[m][bj][n] + acc[ai][bj][m][n];
                        *(f32x4*)(out + o2) = v; ss += (v[0] * v[0] + v[1] * v[1]) + (v[2] * v[2] + v[3] * v[3]);
                        u32x2 w; w.x = cvt_pk_bf16(v[0], v[1]); w.y = cvt_pk_bf16(v[2], v[3]); *(u32x2*)(xb + o2) = w;
                    }
                ss += __shfl_xor(ss, 16); ss += __shfl_xor(ss, 32);
                if (fq == 0) ssp[(size_t)row * 32 + u.pn * 4 + wc] = ss;
            }
            asm volatile("" ::: "memory");
        }
    }
};
struct EpiRelu2 {
    static constexpr bool HAS_MID = false; static constexpr int T1 = -1, T2 = -1; static constexpr bool PERM = true, AFTER_DRAIN = false;
    bf16_t* U; const PG8_LAS float* rst;
    __device__ __forceinline__ void operator()(const f32x4 (&acc)[2][2][4][2], const Unit& u, int wr, int wc, int fr, int fq) const {
        const int row0 = u.pm * BM + wr * 64 + fr, col0 = u.pn * BM + wc * 32 + 8 * fq;
#pragma unroll
        for (int ai = 0; ai < 2; ++ai)
#pragma unroll
            for (int m = 0; m < 4; ++m) {
                bf16_t* rowp = U + (size_t)(row0 + ai * HALF + m * 16) * 8192 + col0;
                const float rs = rst[wr * 64 + fr + ai * HALF + m * 16];
#pragma unroll
                for (int bj = 0; bj < 2; ++bj) {
                    f32x4 v0 = acc[ai][bj][m][0], v1 = acc[ai][bj][m][1];
#pragma unroll
                    for (int e = 0; e < 4; ++e) { const float a = fmaxf(v0[e], 0.f) * rs, b = fmaxf(v1[e], 0.f) * rs; v0[e] = a * a; v1[e] = b * b; }
                    store8bf(rowp + bj * HALF, v0, v1);
                }
            }
    }
};

template <class Epi, class Sched, bool ALIGN_EPI = false, bool SP2 = false>
__device__ __forceinline__ void gemm_phase(PG8_LAS unsigned char* lds, const Gemm g, const Sched& S, const Epi& E) {
    int tid_ = threadIdx.x; asm volatile("" : "+v"(tid_)); const int tid = tid_, wid = __builtin_amdgcn_readfirstlane(tid >> 6), lane = tid & 63, wr = wid >> 2, wc = wid & 3, fr = lane & 15, fq = lane >> 4;
    const int K = g.K, nt = K / BK;
    unsigned voffA[2], voffB[2];
#pragma unroll
    for (int i = 0; i < 2; ++i) { int R, C; stage_rc(tid * 16 + i * 8192, R, C); const int Rb = Epi::PERM ? ((R & ~31) + perm32(R & 31)) : R;
        voffA[i] = (unsigned)(R * K + C) * 2u; voffB[i] = (unsigned)(Rb * K + C) * 2u; }
    const size_t kstep = (size_t)(BK * 2);
    const size_t hstep = (size_t)HALF * K * 2;
    const size_t tstep = 2 * hstep;
    const unsigned ldsw = (unsigned)wid * 1024u;
    const int aoff = lds_byte(wr * 64 + fr, fq * 8), boff = lds_byte(wc * 32 + fr, fq * 8);
#define PG8_SA(b, h) (((b) * 2 + (h)) * HTB)
#define PG8_SB(b, h) ((4 + (b) * 2 + (h)) * HTB)
#define PG8_STAGE(bufoff, gbase, voff) do { _Pragma("unroll") for (int _i = 0; _i < 2; ++_i) \
        __builtin_amdgcn_global_load_lds((const unsigned*)((const char*)(gbase) + (voff)[_i]), (PG8_LAS unsigned*)(lds + (bufoff) + ldsw + _i * 8192), 16, 0, 0); } while (0)
#define PG8_LDA(dst, b, h) do { _Pragma("unroll") for (int m = 0; m < 4; ++m) _Pragma("unroll") for (int k = 0; k < 2; ++k) dst[m][k] = *(const PG8_LAS bf16x8*)(lds + PG8_SA(b, h) + aoff + m * 2048 + k * 1024); } while (0)
#define PG8_LDB(dst, b, h) do { _Pragma("unroll") for (int n = 0; n < 2; ++n) _Pragma("unroll") for (int k = 0; k < 2; ++k) dst[n][k] = *(const PG8_LAS bf16x8*)(lds + PG8_SB(b, h) + boff + n * 2048 + k * 1024); } while (0)
#define PG8_MMA(ai, bj, At, Bt) do { __builtin_amdgcn_s_setprio(1); _Pragma("unroll") for (int m = 0; m < 4; ++m) _Pragma("unroll") for (int n = 0; n < 2; ++n) _Pragma("unroll") for (int k = 0; k < 2; ++k) \
        acc[ai][bj][m][n] = __builtin_amdgcn_mfma_f32_16x16x32_bf16(Bt[n][k], At[m][k], acc[ai][bj][m][n], 0, 0, 0); __builtin_amdgcn_s_setprio(0); } while (0)
#define PG8_WAIT_V(n) asm volatile("s_waitcnt vmcnt(" #n ")" ::: "memory")
#define PG8_WAIT_L(n) asm volatile("s_waitcnt lgkmcnt(" #n ")" ::: "memory")
#define PG8_BAR __builtin_amdgcn_s_barrier()
#define PG8_SCHED __builtin_amdgcn_sched_barrier(0)
    Unit cur, nxt; int ui = 0;
    if (!S.next(0, cur)) return;
    f32x4 acc[2][2][4][2];
#pragma unroll
    for (int a = 0; a < 2; ++a)
#pragma unroll
        for (int b = 0; b < 2; ++b)
#pragma unroll
            for (int m = 0; m < 4; ++m)
#pragma unroll
                for (int n = 0; n < 2; ++n) acc[a][b][m][n] = (f32x4){0.f, 0.f, 0.f, 0.f};
    bf16x8 At[4][2], B0[2][2], B1[2][2];
    const char* cA = (const char*)g.A + (size_t)cur.pm * tstep; const char* cB = (const char*)g.Bt + (size_t)cur.pn * tstep;
    S.a_ready(cur);
    if constexpr (SP2) {
        PG8_STAGE(PG8_SB(0, 0), cB, voffB); PG8_STAGE(PG8_SB(0, 1), cB + hstep, voffB); PG8_STAGE(PG8_SA(0, 0), cA, voffA); PG8_STAGE(PG8_SA(0, 1), cA + hstep, voffA);
        if (wr == 1) PG8_BAR;
        PG8_WAIT_V(2); PG8_BAR;
        PG8_STAGE(PG8_SB(1, 0), cB + kstep, voffB); PG8_STAGE(PG8_SA(1, 0), cA + kstep, voffA); PG8_STAGE(PG8_SB(1, 1), cB + hstep + kstep, voffB);
        PG8_WAIT_V(6); PG8_BAR;
    } else {
        PG8_STAGE(PG8_SB(0, 0), cB, voffB); PG8_STAGE(PG8_SA(0, 0), cA, voffA); PG8_STAGE(PG8_SB(0, 1), cB + hstep, voffB); PG8_STAGE(PG8_SA(0, 1), cA + hstep, voffA);
        if (wr == 1) PG8_BAR;
        PG8_WAIT_V(4); PG8_BAR;
        PG8_STAGE(PG8_SB(1, 0), cB + kstep, voffB); PG8_STAGE(PG8_SA(1, 0), cA + kstep, voffA); PG8_STAGE(PG8_SB(1, 1), cB + hstep + kstep, voffB);
        PG8_WAIT_V(6); PG8_BAR;
    }
    for (;;) {
        const bool has_next = S.next(ui + 1, nxt);
        const char* nA = has_next ? (const char*)g.A + (size_t)nxt.pm * tstep : cA; const char* nB = has_next ? (const char*)g.Bt + (size_t)nxt.pn * tstep : cB;
        for (int t = 0; t < nt; t += 2) {
            if constexpr (Epi::HAS_MID) { if (t == Epi::T1 || t == Epi::T2) E.mid(acc, cur, t, wr, wc, fr, fq); }
            const bool last = (t == nt - 2);
            const char* a1 = cA + (size_t)(t + 1) * kstep;
            const char* a2 = last ? nA : cA + (size_t)(t + 2) * kstep; const char* b2 = last ? nB : cB + (size_t)(t + 2) * kstep;
            const char* a3 = a2 + kstep; const char* b3 = b2 + kstep;
            if (last && has_next) S.a_ready(nxt);
            if constexpr (SP2) {
            PG8_LDB(B0, 0, 0); PG8_LDB(B1, 0, 1); PG8_SCHED; PG8_LDA(At, 0, 0); PG8_STAGE(PG8_SA(1, 1), a1 + hstep, voffA);
            PG8_WAIT_V(8); PG8_WAIT_L(0); PG8_BAR; PG8_MMA(0, 0, At, B0); PG8_MMA(0, 1, At, B1); PG8_BAR; PG8_SCHED;
            PG8_LDA(At, 0, 1); PG8_STAGE(PG8_SB(0, 0), b2, voffB); PG8_STAGE(PG8_SB(0, 1), b2 + hstep, voffB); PG8_STAGE(PG8_SA(0, 0), a2, voffA);
            PG8_WAIT_V(8); PG8_WAIT_L(0); PG8_BAR; PG8_MMA(1, 0, At, B0); PG8_MMA(1, 1, At, B1); PG8_BAR; PG8_SCHED;
            PG8_LDB(B0, 1, 0); PG8_LDB(B1, 1, 1); PG8_SCHED; PG8_LDA(At, 1, 0); PG8_STAGE(PG8_SA(0, 1), a2 + hstep, voffA);
            PG8_WAIT_V(8); PG8_WAIT_L(0); PG8_BAR; PG8_MMA(0, 0, At, B0); PG8_MMA(0, 1, At, B1); PG8_BAR; PG8_SCHED;
            PG8_LDA(At, 1, 1); PG8_STAGE(PG8_SB(1, 0), b3, voffB); PG8_STAGE(PG8_SB(1, 1), b3 + hstep, voffB); PG8_STAGE(PG8_SA(1, 0), a3, voffA);
            PG8_WAIT_V(8); PG8_WAIT_L(0); PG8_BAR; PG8_MMA(1, 0, At, B0); PG8_MMA(1, 1, At, B1); PG8_BAR; PG8_SCHED;
            } else {
            PG8_LDB(B0, 0, 0); PG8_SCHED; PG8_LDA(At, 0, 0); PG8_STAGE(PG8_SA(1, 1), a1 + hstep, voffA);
            PG8_WAIT_L(8); PG8_BAR; PG8_WAIT_L(0); PG8_MMA(0, 0, At, B0); PG8_BAR; PG8_SCHED;
            PG8_LDB(B1, 0, 1); PG8_STAGE(PG8_SB(0, 0), b2, voffB);
            PG8_BAR; PG8_WAIT_L(0); PG8_MMA(0, 1, At, B1); PG8_BAR;
            PG8_LDA(At, 0, 1); PG8_STAGE(PG8_SA(0, 0), a2, voffA);
            PG8_BAR; PG8_WAIT_L(0); PG8_MMA(1, 0, At, B0); PG8_BAR; PG8_SCHED;
            PG8_STAGE(PG8_SB(0, 1), b2 + hstep, voffB);
            PG8_WAIT_V(6); PG8_BAR; PG8_MMA(1, 1, At, B1); PG8_BAR;
            PG8_LDB(B0, 1, 0); PG8_SCHED; PG8_LDA(At, 1, 0); PG8_STAGE(PG8_SA(0, 1), a2 + hstep, voffA);
            PG8_WAIT_L(8); PG8_BAR; PG8_WAIT_L(0); PG8_MMA(0, 0, At, B0); PG8_BAR; PG8_SCHED;
            PG8_LDB(B1, 1, 1); PG8_STAGE(PG8_SB(1, 0), b3, voffB);
            PG8_BAR; PG8_WAIT_L(0); PG8_MMA(0, 1, At, B1); PG8_BAR;
            PG8_LDA(At, 1, 1); PG8_STAGE(PG8_SA(1, 0), a3, voffA);
            PG8_BAR; PG8_WAIT_L(0); PG8_MMA(1, 0, At, B0); PG8_BAR; PG8_SCHED;
            PG8_STAGE(PG8_SB(1, 1), b3 + hstep, voffB);
            PG8_WAIT_V(6); PG8_BAR; PG8_MMA(1, 1, At, B1); PG8_BAR;
            }
        }
        if constexpr (ALIGN_EPI) { if (wr == 0) PG8_BAR; }
        if constexpr (!Epi::AFTER_DRAIN) { E(acc, cur, wr, wc, fr, fq); S.done(cur); }
        if (!has_next) break;
#pragma unroll
        for (int a = 0; a < 2; ++a)
#pragma unroll
            for (int b = 0; b < 2; ++b)
#pragma unroll
                for (int m = 0; m < 4; ++m)
#pragma unroll
                    for (int n = 0; n < 2; ++n) acc[a][b][m][n] = (f32x4){0.f, 0.f, 0.f, 0.f};
        cur = nxt; cA = nA; cB = nB; ++ui;
        if constexpr (ALIGN_EPI) { if (wr == 1) PG8_BAR; }
    }
    PG8_WAIT_V(0);
    if constexpr (!ALIGN_EPI) { if (wr == 0) PG8_BAR; }
    PG8_BAR;
    if constexpr (Epi::AFTER_DRAIN) { E.fused(acc, cur, wr, wc, fr, fq, lds, wid, lane); S.done(cur); }
#undef PG8_SA
#undef PG8_SB
#undef PG8_STAGE
#undef PG8_LDA
#undef PG8_LDB
#undef PG8_MMA
#undef PG8_WAIT_V
#undef PG8_WAIT_L
#undef PG8_BAR
#undef PG8_SCHED
}
}
#ifndef DUPMASK
#define DUPMASK 0
#endif

#define LAS __attribute__((address_space(3)))
typedef unsigned short bf16;
typedef unsigned v4u __attribute__((ext_vector_type(4)));
typedef unsigned v2u __attribute__((ext_vector_type(2)));
typedef float f32x4 __attribute__((ext_vector_type(4)));
typedef short bf16x8 __attribute__((ext_vector_type(8)));
typedef short s16x4 __attribute__((ext_vector_type(4)));

constexpr int DM = 2048, NB = 4, SEQ = 2048, TOK = NB * SEQ, DFF = 8192, PITCH = 16640, NLAYER = 2;
constexpr int COL_AQ = 0, COL_AKC = 1024, COL_AVC = 1280, COL_AKS = 1536, COL_AVS = 1792, COL_AKW = 2048, COL_AVW = 2304,
              COL_BQ = 2560, COL_BK = 4096, COL_BV = 5632, COL_CQ = 7168, COL_CK = 8192, COL_CV = 9216,
              COL_MA = 10240, COL_MB = 12288, COL_MC = 14336, COL_AG = 16384;
constexpr int IN_W = 16408, GMP = 6400;
__device__ __forceinline__ size_t hmo(int b, int hidx) { return ((size_t)(b * 80 + hidx) * 2048) << 7; }
static_assert(PITCH == pg8::IP_PITCH, "pitch");

constexpr size_t MiB = 1u << 20;
constexpr size_t WS_QCTR = 32768;
constexpr size_t WS_CTL = 65536;
constexpr size_t WS_BIAS = 0;
constexpr size_t WS_ROPE = 1 * MiB;
constexpr size_t WS_BIASP = WS_ROPE + 512 * 1024;
constexpr size_t WS_WIN = 2 * MiB;
constexpr size_t WS_WMI = WS_WIN + 130 * MiB;
constexpr size_t WS_WMO = WS_WMI + 64 * MiB;
constexpr size_t WS_WO = WS_WMO + 64 * MiB;
constexpr size_t WS_WBA = WS_WO + 16 * MiB;
constexpr size_t WS_WBB = WS_WBA + 8 * MiB;
constexpr size_t WS_WBC = WS_WBB + 4 * MiB;
constexpr size_t WS_W1T = WS_WBC + 8 * MiB;
constexpr size_t WS_W2T = WS_W1T + 8 * MiB;
constexpr size_t WS_H = WS_W2T + 1 * MiB;
constexpr size_t WS_P = WS_H + 32 * MiB;
constexpr size_t WS_GM = WS_P + 160 * MiB;
constexpr size_t WS_QR = WS_P + 260 * MiB;
constexpr size_t WS_KC = WS_QR + 16 * MiB;
constexpr size_t WS_VC = WS_KC + 1 * MiB;
constexpr size_t WS_KMEAN = WS_VC + 1 * MiB;
constexpr size_t WS_SELM = WS_KMEAN + 1 * MiB;
constexpr size_t WS_OA = WS_SELM + 1 * MiB;
constexpr size_t WS_OC = WS_OA + 16 * MiB;
constexpr size_t WS_OG = WS_OC + 16 * MiB;
constexpr size_t WS_LSE = WS_OG + 24 * MiB;
constexpr size_t WS_OB = WS_LSE + 1 * MiB;
constexpr size_t WS_TMP = WS_OB + 8 * MiB;
constexpr size_t WS_MG = WS_TMP + 64 * MiB;
constexpr size_t WS_X1 = WS_MG + 32 * MiB;
constexpr size_t WS_X2 = WS_X1 + 64 * MiB;
constexpr size_t WS_U = WS_P;
constexpr size_t WS_SSP = WS_X2 + 64 * MiB;
constexpr size_t WS_END = WS_SSP + 5 * MiB;

constexpr int LDS_BYTES = 147456;

__device__ __forceinline__ unsigned f2bf(float f) { unsigned u = __builtin_bit_cast(unsigned, f); return (u + 0x7fffu + ((u >> 16) & 1u)) >> 16; }
__device__ __forceinline__ unsigned pk2(float lo, float hi) { return f2bf(lo) | (f2bf(hi) << 16); }
__device__ __forceinline__ float bf2f(bf16 b) { return __uint_as_float(((unsigned)b) << 16); }
__device__ __forceinline__ float sigm(float x) { return 1.0f / (1.0f + __expf(-x)); }
__device__ __forceinline__ float wave_sum(float v) {
#pragma unroll
    for (int o = 1; o < 64; o <<= 1) v += __shfl_xor(v, o);
    return v;
}
__device__ __forceinline__ int ltid() { int t = threadIdx.x; asm volatile("" : "+v"(t)); return t; }
__device__ __forceinline__ int lbid() { int t = blockIdx.x; asm volatile("" : "+s"(t)); return t; }
#define LDS_WAIT() asm volatile("s_waitcnt lgkmcnt(0)" ::: "memory")

struct Ctx {
    const float* in[17]; float* out; unsigned char* ws;
};

template <bool FRAG = false>
__device__ __forceinline__ void tr_item(const float* W, int K, int Nsrc, int src_n0, int nvalid, bf16* WT, int dst_row0, int k0, LAS float* scr, int lane, const float* gvec = nullptr, int dK = 0) {
    if (dK == 0) dK = K;
    {
        const int kr = lane >> 4, c4 = lane & 15;
        f32x4 v[16];
        const float* wp = W + (size_t)(k0 + kr) * Nsrc + src_n0 + 4 * c4;
#pragma unroll
        for (int i = 0; i < 16; ++i) v[i] = (4 * c4 < nvalid) ? *(const f32x4*)(wp + (size_t)(4 * i) * Nsrc) : (f32x4){0.f, 0.f, 0.f, 0.f};
#pragma unroll
        for (int i = 0; i < 16; ++i) { const float gk = gvec ? gvec[k0 + 4 * i + kr] : 1.0f; LAS float* sp = scr + (4 * i + kr) * 65 + 4 * c4; sp[0] = v[i][0] * gk; sp[1] = v[i][1] * gk; sp[2] = v[i][2] * gk; sp[3] = v[i][3] * gk; }
    }
    LDS_WAIT(); asm volatile("" ::: "memory");
    const int c = lane & 7;
#pragma unroll
    for (int j = 0; j < 8; ++j) {
        const int n = (lane >> 3) + 8 * j; const LAS float* s = scr + (8 * c) * 65 + n;
        v4u o; o.x = pk2(s[0 * 65], s[1 * 65]); o.y = pk2(s[2 * 65], s[3 * 65]); o.z = pk2(s[4 * 65], s[5 * 65]); o.w = pk2(s[6 * 65], s[7 * 65]);
        if (FRAG) {
            const int f = dst_row0 + n, k8 = (k0 >> 3) + c;
            *(v4u*)(WT + ((size_t)(((k8 >> 2) * 16 + (f >> 4)) * 64 + (k8 & 3) * 16 + (f & 15)) << 3)) = o;
        } else if (n < nvalid) *(v4u*)(WT + (size_t)(dst_row0 + n) * dK + k0 + 8 * c) = o;
    }
    LDS_WAIT(); asm volatile("" ::: "memory");
}
template <bool FRAG = false>
__device__ __forceinline__ bool tr_mat(int& r, const float* W, int K, int N, bf16* WT, LAS float* scr, int lane, const float* gvec = nullptr, int dK = 0) {
    const int nblk = N / 64, items = (K / 64) * nblk;
    if (r < items) { const int kb = r / nblk, nb = r % nblk; tr_item<FRAG>(W, K, N, nb * 64, 64, WT, nb * 64, kb * 64, scr, lane, gvec, dK); return true; }
    r -= items; return false;
}
__device__ __forceinline__ void phase_prep(const Ctx& C, LAS unsigned char* lds, bool do_bias) {
    const int tid = ltid(), lane = tid & 63, wave = tid >> 6;
    const int gw = lbid() * 8 + wave, NGW = gridDim.x * 8;
    unsigned char* ws = C.ws;
    LAS float* scr = (LAS float*)(lds + wave * 16640);
    constexpr int I_IN = 32 * 257;
    constexpr int PER_LAYER = I_IN + 16 * 32 + 8 * 32 + 16 * 32 + 32 * 32 + 32 * 128 + 128 * 32 + 64 * 4 + 4 * 2 + 64 * 4 + 4 * 2;
    for (int it = gw; it < 2 * PER_LAYER; it += NGW) {
        const int l = it / PER_LAYER; int r = it % PER_LAYER;
        if (r < I_IN) {
            const int kb = r / 257, nb = r % 257; const int n0 = nb * 64;
            const int src0 = (n0 < 2560) ? n0 : (n0 < 16384 ? n0 + 24 : 2560);
            tr_item(C.in[2] + (size_t)l * DM * IN_W, DM, IN_W, src0, nb == 256 ? 24 : 64, (bf16*)(ws + WS_WIN) + (size_t)l * PITCH * DM, n0, kb * 64, scr, lane, C.in[1] + (size_t)l * DM);
            continue;
        }
        r -= I_IN;
        if (tr_mat(r, C.in[9] + (size_t)l * 1024 * DM, 1024, DM, (bf16*)(ws + WS_WBA) + (size_t)l * DM * 2560, scr, lane, nullptr, 2560)) continue;
        if (tr_mat(r, C.in[10] + (size_t)l * 512 * DM, 512, DM, (bf16*)(ws + WS_WBA) + (size_t)l * DM * 2560 + 1024, scr, lane, nullptr, 2560)) continue;
        if (tr_mat(r, C.in[11] + (size_t)l * 1024 * DM, 1024, DM, (bf16*)(ws + WS_WBA) + (size_t)l * DM * 2560 + 1536, scr, lane, nullptr, 2560)) continue;
        if (tr_mat(r, C.in[12] + (size_t)l * DM * DM, DM, DM, (bf16*)(ws + WS_WO) + (size_t)l * DM * DM, scr, lane)) continue;
        if (tr_mat(r, C.in[14] + (size_t)l * DM * DFF, DM, DFF, (bf16*)(ws + WS_WMI) + (size_t)l * DFF * DM, scr, lane, C.in[13] + (size_t)l * DM)) continue;
        if (tr_mat(r, C.in[15] + (size_t)l * DFF * DM, DFF, DM, (bf16*)(ws + WS_WMO) + (size_t)l * DM * DFF, scr, lane)) continue;
        if (tr_mat<true>(r, C.in[4] + (size_t)l * 4096 * 256, 4096, 256, (bf16*)(ws + WS_W1T) + (size_t)(l * 2 + 0) * 256 * 4096, scr, lane)) continue;
        if (tr_mat(r, C.in[5] + (size_t)l * 256 * 128, 256, 128, (bf16*)(ws + WS_W2T) + (size_t)(l * 2 + 0) * 128 * 256, scr, lane)) continue;
        if (tr_mat<true>(r, C.in[7] + (size_t)l * 4096 * 256, 4096, 256, (bf16*)(ws + WS_W1T) + (size_t)(l * 2 + 1) * 256 * 4096, scr, lane)) continue;
        tr_mat(r, C.in[8] + (size_t)l * 256 * 128, 256, 128, (bf16*)(ws + WS_W2T) + (size_t)(l * 2 + 1) * 128 * 256, scr, lane);
    }
    float* rope = (float*)(ws + WS_ROPE);
    for (int e = lbid() * 512 + tid; e < 2048 * 16; e += gridDim.x * 512) {
        const int t = e >> 4, i = e & 15;
        const float inv = powf(500000.0f, -(float)(2 * i) / 32.0f);
        const float ang = (float)t * inv;
        rope[e] = cosf(ang); rope[2048 * 16 + e] = sinf(ang);
    }
    float* bias = (float*)(ws + WS_BIASP);
    if (do_bias) for (int task = gw; task < 4 * 4 * 32; task += NGW) {
        const int kc = task & 31, fc = (task >> 5) & 3, lk = task >> 7, l = lk >> 1, kv = lk & 1;
        const float* pe = C.in[kv ? 6 : 3] + (size_t)l * 4096;
        const float* w1 = C.in[kv ? 7 : 4] + (size_t)l * 4096 * 256;
        float acc = 0.f;
#pragma unroll 8
        for (int k = kc * 128; k < kc * 128 + 128; ++k) acc += pe[k] * w1[(size_t)k * 256 + fc * 64 + lane];
        bias[(lk * 32 + kc) * 256 + fc * 64 + lane] = acc;
    }
}

__device__ __forceinline__ void phase_cast(const float* x, bf16* ob, float* ssp) {
    const int tid = ltid(), lane = tid & 63, wave = tid >> 6;
    const int gw = lbid() * 8 + wave, NGW = gridDim.x * 8;
    for (int row = gw; row < TOK; row += NGW) {
        const float* xr = x + (size_t)row * DM;
        f32x4 v[8]; float ss = 0.f;
#pragma unroll
        for (int j = 0; j < 8; ++j) { v[j] = *(const f32x4*)(xr + (64 * j + lane) * 4); ss += (v[j][0] * v[j][0] + v[j][1] * v[j][1]) + (v[j][2] * v[j][2] + v[j][3] * v[j][3]); }
        ss = wave_sum(ss);
#pragma unroll
        for (int j = 0; j < 8; ++j) { v2u w; w.x = pk2(v[j][0], v[j][1]); w.y = pk2(v[j][2], v[j][3]); *(v2u*)(ob + (size_t)row * DM + (64 * j + lane) * 4) = w; }
        if (lane < 32) ssp[(size_t)row * 32 + lane] = (lane == 0) ? ss : 0.f;
    }
}
__device__ __forceinline__ void phase_final(const float* x, const float* g, const float* ssp, float* of) {
    const int tid = ltid(), lane = tid & 63, wave = tid >> 6;
    const int gw = lbid() * 8 + wave, NGW = gridDim.x * 8;
    f32x4 gv[8];
#pragma unroll
    for (int j = 0; j < 8; ++j) gv[j] = *(const f32x4*)(g + (64 * j + lane) * 4);
    for (int row = gw; row < TOK; row += NGW) {
        const float rs = pg8::row_rscale(ssp, row);
        const float* xr = x + (size_t)row * DM;
#pragma unroll
        for (int j = 0; j < 8; ++j) { const f32x4 y = *(const f32x4*)(xr + (64 * j + lane) * 4) * rs * gv[j]; *(f32x4*)(of + (size_t)row * DM + (64 * j + lane) * 4) = y; }
    }
}
template <bool OUTF32>
__device__ __forceinline__ void phase_norm(const float* x, const float* g, bf16* ob, float* of) {
    const int tid = ltid(), lane = tid & 63, wave = tid >> 6;
    const int gw = lbid() * 8 + wave, NGW = gridDim.x * 8;
    f32x4 gv[8];
#pragma unroll
    for (int j = 0; j < 8; ++j) gv[j] = *(const f32x4*)(g + (64 * j + lane) * 4);
    for (int row = gw; row < TOK; row += NGW) {
        const float* xr = x + (size_t)row * DM;
        f32x4 v[8]; float ss = 0.f;
#pragma unroll
        for (int j = 0; j < 8; ++j) { v[j] = *(const f32x4*)(xr + (64 * j + lane) * 4); ss += (v[j][0] * v[j][0] + v[j][1] * v[j][1]) + (v[j][2] * v[j][2] + v[j][3] * v[j][3]); }
        const float rs = rsqrtf(wave_sum(ss) * (1.0f / DM) + 1e-6f);
#pragma unroll
        for (int j = 0; j < 8; ++j) {
            const f32x4 y = v[j] * rs * gv[j];
            if (OUTF32) *(f32x4*)(of + (size_t)row * DM + (64 * j + lane) * 4) = y;
            else { v2u w; w.x = pk2(y[0], y[1]); w.y = pk2(y[2], y[3]); *(v2u*)(ob + (size_t)row * DM + (64 * j + lane) * 4) = w; }
        }
    }
}

namespace att {
constexpr int KP = 288, VP = 288, KTB = 64 * KP, VTB = 64 * VP, BUFB = KTB + VTB;
constexpr int MISC = 2 * BUFB;
constexpr float SC = 0.08838834764831845f * 1.4426950408889634f;
constexpr float NEG_INF = -__builtin_inff();

struct Cfg { const bf16* K; const bf16* V; size_t kstride; int jt_lo, jt_hi, W, bshift; unsigned tor; };
typedef unsigned u32x2_t __attribute__((ext_vector_type(2)));
__device__ __forceinline__ float rows_max(float v) {
    u32x2_t r = __builtin_amdgcn_permlane32_swap(__float_as_uint(v), __float_as_uint(v), false, false);
    const float a = fmaxf(__uint_as_float(r.x), __uint_as_float(r.y));
    r = __builtin_amdgcn_permlane16_swap(__float_as_uint(a), __float_as_uint(a), false, false);
    return fmaxf(__uint_as_float(r.x), __uint_as_float(r.y));
}
__device__ __forceinline__ float rows_sum(float v) {
    u32x2_t r = __builtin_amdgcn_permlane32_swap(__float_as_uint(v), __float_as_uint(v), false, false);
    const float a = __uint_as_float(r.x) + __uint_as_float(r.y);
    r = __builtin_amdgcn_permlane16_swap(__float_as_uint(a), __float_as_uint(a), false, false);
    return __uint_as_float(r.x) + __uint_as_float(r.y);
}

__device__ __forceinline__ bool tile_on(const Cfg& c, int jt) { return c.bshift < 0 || ((c.tor >> ((jt * 64) >> c.bshift)) & 1u); }
__device__ __forceinline__ int next_tile(const Cfg& c, int jt) { while (jt <= c.jt_hi && !tile_on(c, jt)) ++jt; return jt; }

__device__ __forceinline__ void tile_gload(const Cfg& c, int jt, int tid, v4u (&kr)[2], v4u (&vr)[2]) {
#pragma unroll
    for (int i = 0; i < 2; ++i) {
        const int ch = tid + i * 512, row = ch >> 4, c16 = ch & 15;
        const size_t off = (size_t)(jt * 64 + row) * c.kstride + c16 * 8;
        kr[i] = *(const v4u*)(c.K + off); vr[i] = *(const v4u*)(c.V + off);
    }
}
__device__ __forceinline__ void tile_lwrite(LAS unsigned char* buf, int tid, const v4u (&kr)[2], const v4u (&vr)[2]) {
#pragma unroll
    for (int i = 0; i < 2; ++i) {
        const int ch = tid + i * 512, row = ch >> 4, c16 = ch & 15;
        *(LAS v4u*)(buf + row * KP + c16 * 16) = kr[i];
        *(LAS v4u*)(buf + KTB + row * VP + c16 * 16) = vr[i];
    }
}
__device__ __forceinline__ s16x4 vtr(const LAS unsigned char* p) { return __builtin_bit_cast(s16x4, __builtin_amdgcn_ds_read_tr16_b64_v4i16((LAS s16x4*)p)); }
__device__ __forceinline__ bf16x8 pack8(const f32x4& a, const f32x4& b) {
    v4u w; w.x = pg8::cvt_pk_bf16(a[0], a[1]); w.y = pg8::cvt_pk_bf16(a[2], a[3]); w.z = pg8::cvt_pk_bf16(b[0], b[1]); w.w = pg8::cvt_pk_bf16(b[2], b[3]);
    return __builtin_bit_cast(bf16x8, w);
}
template <int NT>
__device__ __forceinline__ void pv_chunk(const LAS unsigned char* vt, int cc, int li, int q4, const bf16x8 (&pf)[NT], f32x4 (&o)[NT][8]) {
    const LAS unsigned char* vp = vt + (cc * 32 + 4 * q4 + (li >> 2)) * VP + (4 * (li & 3)) * 2;
#pragma unroll
    for (int dg = 0; dg < 2; ++dg) {
        s16x4 v0[4], v1[4];
        asm volatile("s_waitcnt lgkmcnt(0)" ::: "memory");
#pragma unroll
        for (int d = 0; d < 4; ++d) { v0[d] = vtr(vp + (dg * 4 + d) * 32); v1[d] = vtr(vp + (dg * 4 + d) * 32 + 16 * VP); }
        __builtin_amdgcn_sched_barrier(0);
#pragma unroll
        for (int d = 0; d < 4; ++d) {
            bf16x8 vf; vf[0] = v0[d][0]; vf[1] = v0[d][1]; vf[2] = v0[d][2]; vf[3] = v0[d][3]; vf[4] = v1[d][0]; vf[5] = v1[d][1]; vf[6] = v1[d][2]; vf[7] = v1[d][3];
#pragma unroll
            for (int nt = 0; nt < NT; ++nt) o[nt][dg * 4 + d] = __builtin_amdgcn_mfma_f32_16x16x32_bf16(vf, pf[nt], o[nt][dg * 4 + d], 0, 0, 0);
        }
        __builtin_amdgcn_sched_barrier(0);
    }
}

template <int NT>
__device__ __forceinline__ void tile_compute(const LAS unsigned char* buf, const Cfg& c, int jt, int lane, const bf16x8 (&qf)[NT][4], const int (&qpos)[NT], const unsigned (&bits)[NT],
                                             f32x4 (&o)[NT][8], float (&m)[NT], float (&l)[NT], int qmin) {
    const int li = lane & 15, q4 = lane >> 4;
    const int k0 = jt * 64, qmax = qmin + 16 * NT - 1;
    bool anyrow = true, allrow = true;
    if (c.bshift >= 0) {
        bool hit = false, all = true;
#pragma unroll
        for (int nt = 0; nt < NT; ++nt) { const bool b = (bits[nt] >> (k0 >> c.bshift)) & 1u; hit = hit || b; all = all && b; }
        anyrow = __builtin_amdgcn_ballot_w64(hit) != 0ull; allrow = __builtin_amdgcn_ballot_w64(!all) == 0ull;
    }
    if (!(k0 <= qmax && qmin - (k0 + 63) < c.W && anyrow)) return;
    const bool full = allrow && (k0 + 63 <= qmin) && (qmax - k0 < c.W);
    f32x4 s[NT][4];
#pragma unroll
    for (int nt = 0; nt < NT; ++nt)
#pragma unroll
        for (int kb = 0; kb < 4; ++kb) s[nt][kb] = (f32x4){0.f, 0.f, 0.f, 0.f};
    const LAS unsigned char* kp = buf + li * KP + q4 * 16;
#pragma unroll
    for (int ks = 0; ks < 4; ++ks)
#pragma unroll
        for (int kb = 0; kb < 4; ++kb) {
            const bf16x8 kf = *(const LAS bf16x8*)(kp + kb * 16 * KP + ks * 64);
#pragma unroll
            for (int nt = 0; nt < NT; ++nt) s[nt][kb] = __builtin_amdgcn_mfma_f32_16x16x32_bf16(kf, qf[nt][ks], s[nt][kb], 0, 0, 0);
        }
    bf16x8 pf[2][NT];
#pragma unroll
    for (int nt = 0; nt < NT; ++nt) {
        float mx = NEG_INF;
        if (full) {
#pragma unroll
            for (int kb = 0; kb < 4; ++kb) mx = fmaxf(mx, fmaxf(fmaxf(s[nt][kb][0], s[nt][kb][1]), fmaxf(s[nt][kb][2], s[nt][kb][3])));
        } else {
            const int hi = qpos[nt] - (jt * 64 + q4 * 4);
            unsigned wrow = (unsigned)c.W;
            if (c.bshift >= 0) wrow = ((bits[nt] >> ((jt * 64) >> c.bshift)) & 1u) ? wrow : 0u;
#pragma unroll
            for (int kb = 0; kb < 4; ++kb)
#pragma unroll
                for (int jj = 0; jj < 4; ++jj) {
                    const bool ok = (unsigned)(hi - (kb * 16 + jj)) < wrow;
                    const float x = ok ? s[nt][kb][jj] : NEG_INF;
                    s[nt][kb][jj] = x; mx = fmaxf(mx, x);
                }
        }
        mx = rows_max(mx);
        const float mn = fmaxf(m[nt], mx), alpha = __builtin_amdgcn_exp2f((m[nt] - mn) * SC);
        m[nt] = mn;
        const float nms = -mn * SC;
        float rs = 0.f;
#pragma unroll
        for (int kb = 0; kb < 4; ++kb)
#pragma unroll
            for (int jj = 0; jj < 4; ++jj) { const float p = __builtin_amdgcn_exp2f(__builtin_fmaf(s[nt][kb][jj], SC, nms)); s[nt][kb][jj] = p; rs += p; }
        rs = rows_sum(rs);
        l[nt] = l[nt] * alpha + rs;
        if (__builtin_amdgcn_ballot_w64(alpha != 1.0f) != 0ull) {
#pragma unroll
            for (int db = 0; db < 8; ++db) o[nt][db] = o[nt][db] * alpha;
        }
        pf[0][nt] = pack8(s[nt][0], s[nt][1]); pf[1][nt] = pack8(s[nt][2], s[nt][3]);
    }
    const LAS unsigned char* vt = buf + KTB;
    pv_chunk<NT>(vt, 0, li, q4, pf[0], o);
    pv_chunk<NT>(vt, 1, li, q4, pf[1], o);
}

template <int NT>
__device__ __forceinline__ void run_attn(LAS unsigned char* lds, const Cfg& c, const bf16* qbase, const unsigned (&qoff)[NT], const int (&qpos)[NT], const unsigned (&bits)[NT],
                                         bf16* dbase, const unsigned (&doff)[NT], const float (&gate)[NT], bool accum, float* lsebase) {
    const int tid = ltid(), lane = tid & 63, li = lane & 15, q4 = lane >> 4;
    bf16x8 qf[NT][4];
#pragma unroll
    for (int nt = 0; nt < NT; ++nt)
#pragma unroll
        for (int ks = 0; ks < 4; ++ks) qf[nt][ks] = *(const bf16x8*)(qbase + (size_t)qoff[nt] + ks * 32 + q4 * 8);
    f32x4 o[NT][8]; float m[NT], l[NT];
#pragma unroll
    for (int nt = 0; nt < NT; ++nt) {
        m[nt] = -1e30f; l[nt] = 0.f;
#pragma unroll
        for (int db = 0; db < 8; ++db) o[nt][db] = (f32x4){0.f, 0.f, 0.f, 0.f};
    }
    const int qmin = __builtin_amdgcn_readfirstlane(qpos[0]);
    __syncthreads();
#define ATT_BAR() do { asm volatile("s_waitcnt lgkmcnt(0)" ::: "memory"); __builtin_amdgcn_s_barrier(); asm volatile("" ::: "memory"); } while (0)
    int jt = next_tile(c, c.jt_lo);
    if (jt <= c.jt_hi) {
        v4u ka[2], va[2], kb[2], vb[2];
        tile_gload(c, jt, tid, ka, va);
        tile_lwrite(lds, tid, ka, va);
        int jn = next_tile(c, jt + 1);
        if (jn <= c.jt_hi) tile_gload(c, jn, tid, ka, va);
        ATT_BAR();
        int bsel = 0;
        for (;;) {
            int jn2 = (jn <= c.jt_hi) ? next_tile(c, jn + 1) : jn;
            if (jn2 <= c.jt_hi) tile_gload(c, jn2, tid, kb, vb);
            tile_compute<NT>(lds + bsel * BUFB, c, jt, lane, qf, qpos, bits, o, m, l, qmin);
            if (jn <= c.jt_hi) tile_lwrite(lds + (bsel ^ 1) * BUFB, tid, ka, va);
            ATT_BAR();
            if (jn > c.jt_hi) break;
            jt = jn; jn = jn2; bsel ^= 1;
            jn2 = (jn <= c.jt_hi) ? next_tile(c, jn + 1) : jn;
            if (jn2 <= c.jt_hi) tile_gload(c, jn2, tid, ka, va);
            tile_compute<NT>(lds + bsel * BUFB, c, jt, lane, qf, qpos, bits, o, m, l, qmin);
            if (jn <= c.jt_hi) tile_lwrite(lds + (bsel ^ 1) * BUFB, tid, kb, vb);
            ATT_BAR();
            if (jn > c.jt_hi) break;
            jt = jn; jn = jn2; bsel ^= 1;
        }
    }
#undef ATT_BAR
#pragma unroll
    for (int nt = 0; nt < NT; ++nt) {
        const float sc = gate[nt] / fmaxf(l[nt], 1e-30f);
        bf16* dp = dbase + (size_t)doff[nt] + q4 * 4;
#pragma unroll
        for (int db = 0; db < 8; ++db) {
            f32x4 v = o[nt][db] * sc;
            if (accum) { const unsigned long long ow = __hip_atomic_load((const unsigned long long*)(dp + db * 16), __ATOMIC_RELAXED, __HIP_MEMORY_SCOPE_AGENT); v2u old; old.x = (unsigned)ow; old.y = (unsigned)(ow >> 32); v[0] += pg8::bf_lo(old.x); v[1] += pg8::bf_hi(old.x); v[2] += pg8::bf_lo(old.y); v[3] += pg8::bf_hi(old.y); }
            v2u w; w.x = pg8::cvt_pk_bf16(v[0], v[1]); w.y = pg8::cvt_pk_bf16(v[2], v[3]);
            *(v2u*)(dp + db * 16) = w;
        }
        if (lsebase != nullptr && q4 == 0) lsebase[doff[nt] >> 7] = (m[nt] * SC + log2f(fmaxf(l[nt], 1e-30f))) * 0.6931471805599453f;
    }
}
}

struct Bufs {
    bf16 *P, *GM, *QR, *KC, *VC, *OA, *OC, *OG, *OB; float *KMEAN, *LSE; unsigned* SELM;
};

template <int NT>
__device__ __forceinline__ void unit_dilated(LAS unsigned char* lds, const Bufs& B, int gi, int r, int b, int hh, int cls, int i0) {
    const int tid = ltid(), lane = tid & 63, wave = tid >> 6, li = lane & 15;
    constexpr int ROWS = NT * 128;
    const int head = gi * 4 + hh;
    att::Cfg c;
    c.K = B.P + hmo(b, 32 + head) + cls * 128; c.V = B.P + hmo(b, 44 + head) + cls * 128; c.kstride = (size_t)r * 128;
    c.jt_lo = (i0 >= 128) ? ((i0 - 128) >> 6) : 0; c.jt_hi = (i0 + ROWS - 1) >> 6; c.W = 129; c.bshift = -1; c.tor = 0u;
    unsigned qoff[NT]; int qpos[NT]; unsigned bits[NT]; unsigned doff[NT]; float gate[NT];
#pragma unroll
    for (int nt = 0; nt < NT; ++nt) {
        const int i = i0 + NT * 16 * wave + 16 * nt + li, tok = cls + r * i;
        qoff[nt] = (unsigned)tok * 128u; qpos[nt] = i; bits[nt] = 0u;
        doff[nt] = (unsigned)(gi * TOK + b * SEQ + tok) * 512u + hh * 128; gate[nt] = 1.0f;
    }
    att::run_attn<NT>(lds, c, B.P + hmo(b, 20 + head), qoff, qpos, bits, B.OG, doff, gate, false, B.LSE);
}

__device__ __forceinline__ void unit_cmp(LAS unsigned char* lds, const Bufs& B, int uidx) {
    using namespace att;
    const int tid = ltid(), lane = tid & 63, wave = tid >> 6, li = lane & 15, q4 = lane >> 4;
    const int q_blk = uidx & 31, g = (uidx >> 5) & 1, b = uidx >> 6;
    __syncthreads();
    {
        const bf16* Kc = B.KC + (size_t)((b * 2 + g) * 128) * 128; const bf16* Vc = B.VC + (size_t)((b * 2 + g) * 128) * 128;
#pragma unroll
        for (int i = 0; i < 4; ++i) {
            const int ch = tid + i * 512, row = ch >> 4, c16 = ch & 15, bf = row >> 6, rr = row & 63;
            const v4u kv = *(const v4u*)(Kc + row * 128 + c16 * 8), vv = *(const v4u*)(Vc + row * 128 + c16 * 8);
            *(LAS v4u*)(lds + bf * BUFB + rr * KP + c16 * 16) = kv;
            *(LAS v4u*)(lds + bf * BUFB + KTB + rr * VP + c16 * 16) = vv;
        }
    }
    int tt[2], hh[2]; bf16x8 qf[2][4];
#pragma unroll
    for (int nt = 0; nt < 2; ++nt) {
        const int R = 32 * wave + 16 * nt + li; tt[nt] = 64 * q_blk + (R >> 2); hh[nt] = g * 4 + (R & 3);
        const bf16* qp = B.P + hmo(b, hh[nt]) + tt[nt] * 128 + q4 * 8;
#pragma unroll
        for (int ks = 0; ks < 4; ++ks) qf[nt][ks] = *(const bf16x8*)(qp + ks * 32);
    }
    __syncthreads();
    f32x4 s[2][8];
#pragma unroll
    for (int nt = 0; nt < 2; ++nt)
#pragma unroll
        for (int kb = 0; kb < 8; ++kb) s[nt][kb] = (f32x4){0.f, 0.f, 0.f, 0.f};
#pragma unroll
    for (int bf = 0; bf < 2; ++bf) {
        const LAS unsigned char* kp = lds + bf * BUFB + li * KP + q4 * 16;
#pragma unroll
        for (int ks = 0; ks < 4; ++ks)
#pragma unroll
            for (int kb = 0; kb < 4; ++kb) {
                const bf16x8 kf = *(const LAS bf16x8*)(kp + kb * 16 * KP + ks * 64);
#pragma unroll
                for (int nt = 0; nt < 2; ++nt) s[nt][bf * 4 + kb] = __builtin_amdgcn_mfma_f32_16x16x32_bf16(kf, qf[nt][ks], s[nt][bf * 4 + kb], 0, 0, 0);
            }
    }
    LAS float* impbuf = (LAS float*)(lds + MISC);
    bf16x8 pf[4][2];
#pragma unroll
    for (int nt = 0; nt < 2; ++nt) {
        const int qpos = (tt[nt] >= 31) ? ((tt[nt] - 31) >> 4) : -1;
        float mx = NEG_INF;
#pragma unroll
        for (int kb = 0; kb < 8; ++kb)
#pragma unroll
            for (int jj = 0; jj < 4; ++jj) { const int j = kb * 16 + q4 * 4 + jj; const float x = (j <= qpos) ? s[nt][kb][jj] * SC : NEG_INF; s[nt][kb][jj] = x; mx = fmaxf(mx, x); }
        mx = fmaxf(mx, __shfl_xor(mx, 16)); mx = fmaxf(mx, __shfl_xor(mx, 32)); mx = fmaxf(mx, -1e30f);
        float rs = 0.f;
#pragma unroll
        for (int kb = 0; kb < 8; ++kb)
#pragma unroll
            for (int jj = 0; jj < 4; ++jj) { const float p = __builtin_amdgcn_exp2f(s[nt][kb][jj] - mx); s[nt][kb][jj] = p; rs += p; }
        rs += __shfl_xor(rs, 16); rs += __shfl_xor(rs, 32);
        const float inv = 1.0f / fmaxf(rs, 1e-30f);
        float xprev = 0.f;
#pragma unroll
        for (int kb = 0; kb < 8; ++kb) {
            s[nt][kb] = s[nt][kb] * inv;
            const float own = (s[nt][kb][0] + s[nt][kb][1]) + (s[nt][kb][2] + 0.5f * s[nt][kb][3]);
            const float x3 = 0.5f * s[nt][kb][3];
            const float snd = (q4 == 3) ? xprev : x3;
            const float rcv = __shfl(snd, (lane + 48) & 63);
            xprev = x3;
            float tot = own + rcv;
            tot += __shfl_xor(tot, 1); tot += __shfl_xor(tot, 2);
            if ((li & 3) == 0) impbuf[(8 * wave + 4 * nt + (li >> 2)) * 32 + kb * 4 + q4] = tot;
        }
#pragma unroll
        for (int c = 0; c < 4; ++c) pf[c][nt] = pack8(s[nt][2 * c], s[nt][2 * c + 1]);
    }
    f32x4 o[2][8];
#pragma unroll
    for (int nt = 0; nt < 2; ++nt)
#pragma unroll
        for (int db = 0; db < 8; ++db) o[nt][db] = (f32x4){0.f, 0.f, 0.f, 0.f};
#pragma unroll
    for (int c = 0; c < 4; ++c) pv_chunk<2>(lds + (c >> 1) * BUFB + KTB, c & 1, li, q4, pf[c], o);
#pragma unroll
    for (int nt = 0; nt < 2; ++nt) {
        const size_t rowg = (size_t)(b * SEQ + tt[nt]);
        const float gate = sigm(bf2f(B.GM[rowg * GMP + 6144 + hh[nt] * 3 + 0]));
        bf16* dp = B.OA + rowg * 2560 + hh[nt] * 128 + q4 * 4;
#pragma unroll
        for (int db = 0; db < 8; ++db) { const f32x4 v = o[nt][db] * gate; v2u w; w.x = pg8::cvt_pk_bf16(v[0], v[1]); w.y = pg8::cvt_pk_bf16(v[2], v[3]); *(v2u*)(dp + db * 16) = w; }
    }
    __syncthreads();
#pragma unroll 1
    for (int i = 0; i < 4; ++i) {
        const int idx = tid + i * 512, tl = idx >> 5, j = idx & 31;
        bool sel;
        if (j > q_blk) sel = false;
        else if (q_blk < 16) sel = true;
        else if (j == 0 || j >= q_blk - 1) sel = true;
        else {
            const float me = impbuf[tl * 32 + j]; int rank = 0;
            for (int jp = 1; jp <= q_blk - 2; ++jp) { const float ov = impbuf[tl * 32 + jp]; rank += ((ov > me) || (ov == me && jp < j)) ? 1 : 0; }
            sel = rank < 13;
        }
        const unsigned long long bal = __ballot(sel);
        if ((lane & 31) == 0) B.SELM[(size_t)(b * SEQ + 64 * q_blk + tl) * 2 + g] = (lane < 32) ? (unsigned)bal : (unsigned)(bal >> 32);
    }
}

__device__ __forceinline__ void unit_nsa(LAS unsigned char* lds, const Bufs& B, int uidx) {
    const int tid = ltid(), lane = tid & 63, wave = tid >> 6, li = lane & 15;
    const int q_blk = uidx & 31, g = (uidx >> 5) & 1, b = uidx >> 6;
    unsigned qoff[2], doff[2]; int qpos[2]; unsigned bits[2]; float gate[2]; int gcol[2];
    unsigned ob = 0u;
#pragma unroll
    for (int nt = 0; nt < 2; ++nt) {
        const int R = 32 * wave + 16 * nt + li, rr = R >> 6, t = 64 * q_blk + (R & 63), h = g * 4 + rr;
        qoff[nt] = (unsigned)((b * 8 + h) * SEQ + t) * 128u; doff[nt] = (unsigned)(b * SEQ + t) * 2560u + h * 128; qpos[nt] = t;
        bits[nt] = __hip_atomic_load(B.SELM + (size_t)(b * SEQ + t) * 2 + g, __ATOMIC_RELAXED, __HIP_MEMORY_SCOPE_AGENT); ob |= bits[nt];
        gcol[nt] = 6144 + h * 3;
    }
#pragma unroll
    for (int o = 1; o < 64; o <<= 1) ob |= __shfl_xor(ob, o);
    LAS unsigned* orw = (LAS unsigned*)(lds + att::MISC);
    __syncthreads();
    if (tid == 0) orw[0] = 0u;
    __syncthreads();
    if (lane == 0) __hip_atomic_fetch_or(orw, ob, __ATOMIC_RELAXED, __HIP_MEMORY_SCOPE_WORKGROUP);
    __syncthreads();
    const unsigned tor = orw[0];
#pragma unroll 1
    for (int pass = 0; pass < 2; ++pass) {
        att::Cfg c;
        c.K = B.P + hmo(b, (pass == 0 ? 12 : 16) + g); c.V = B.P + hmo(b, (pass == 0 ? 14 : 18) + g); c.kstride = 128;
        c.jt_lo = (pass == 0) ? 0 : (q_blk >= 8 ? q_blk - 8 : 0); c.jt_hi = q_blk;
        c.W = (pass == 0) ? (1 << 30) : 512; c.bshift = (pass == 0) ? 6 : -1; c.tor = tor;
#pragma unroll
        for (int nt = 0; nt < 2; ++nt) gate[nt] = sigm(bf2f(B.GM[(size_t)(b * SEQ + qpos[nt]) * GMP + gcol[nt] + 1 + pass]));
        att::run_attn<2>(lds, c, B.QR, qoff, qpos, bits, B.OA, doff, gate, true, nullptr);
    }
}

__device__ __forceinline__ void unit_moba(LAS unsigned char* lds, const Bufs& B, int b, int h, int qb) {
    const int tid = ltid(), lane = tid & 63, wave = tid >> 6, li = lane & 15;
    LAS unsigned* mb = (LAS unsigned*)(lds + att::MISC);
    __syncthreads();
    if (tid == 0) mb[256] = 0u;
    {
        const int row = tid >> 1, half = tid & 1, t = 256 * qb + row;
        const bf16* qp = B.P + hmo(b, 56 + h) + t * 128 + half * 64;
        LAS float* kml = (LAS float*)(lds + att::MISC + 2048);
        if (tid < 224) *(LAS f32x4*)(kml + tid * 4) = *(const f32x4*)(B.KMEAN + (size_t)((b * 8 + h) * 8) * 128 + tid * 4);
        __syncthreads();
        const LAS float* km = kml + half * 64;
        float acc[7];
#pragma unroll
        for (int j = 0; j < 7; ++j) acc[j] = 0.f;
#pragma unroll 2
        for (int ch = 0; ch < 8; ++ch) {
            const v4u qw = *(const v4u*)(qp + ch * 8);
            float q[8]; q[0] = pg8::bf_lo(qw.x); q[1] = pg8::bf_hi(qw.x); q[2] = pg8::bf_lo(qw.y); q[3] = pg8::bf_hi(qw.y); q[4] = pg8::bf_lo(qw.z); q[5] = pg8::bf_hi(qw.z); q[6] = pg8::bf_lo(qw.w); q[7] = pg8::bf_hi(qw.w);
#pragma unroll
            for (int j = 0; j < 7; ++j) if (j < qb) {
                const f32x4 k0 = *(const LAS f32x4*)(km + j * 128 + ch * 8), k1 = *(const LAS f32x4*)(km + j * 128 + ch * 8 + 4);
                acc[j] += (q[0] * k0[0] + q[1] * k0[1]) + (q[2] * k0[2] + q[3] * k0[3]) + (q[4] * k1[0] + q[5] * k1[1]) + (q[6] * k1[2] + q[7] * k1[3]);
            }
        }
        unsigned bt = 0u;
#pragma unroll
        for (int j = 0; j < 7; ++j) acc[j] += __shfl_xor(acc[j], 1);
        if (qb <= 3) bt = (1u << qb) - 1u;
        else {
#pragma unroll
            for (int j = 0; j < 7; ++j) if (j < qb) {
                int rank = 0;
#pragma unroll
                for (int jp = 0; jp < 7; ++jp) if (jp < qb && jp != j) rank += ((acc[jp] > acc[j]) || (acc[jp] == acc[j] && jp < j)) ? 1 : 0;
                if (rank < 3) bt |= 1u << j;
            }
        }
        bt |= 1u << qb;
        if (half == 0) mb[row] = bt;
        unsigned ob = bt;
#pragma unroll
        for (int o = 1; o < 64; o <<= 1) ob |= __shfl_xor(ob, o);
        __syncthreads();
        if (lane == 0) __hip_atomic_fetch_or(mb + 256, ob, __ATOMIC_RELAXED, __HIP_MEMORY_SCOPE_WORKGROUP);
        __syncthreads();
    }
    att::Cfg c;
    c.K = B.P + hmo(b, 64 + h); c.V = B.P + hmo(b, 72 + h); c.kstride = 128; c.jt_lo = 0; c.jt_hi = 4 * qb + 3; c.W = 1 << 30; c.bshift = 8; c.tor = mb[256];
    unsigned qoff[2]; int qpos[2]; unsigned bits[2]; unsigned doff[2]; float gate[2];
#pragma unroll
    for (int nt = 0; nt < 2; ++nt) {
        const int R = 32 * wave + 16 * nt + li, t = 256 * qb + R;
        qoff[nt] = (unsigned)t * 128u; qpos[nt] = t; bits[nt] = mb[R];
        doff[nt] = (unsigned)(b * SEQ + t) * 2560u + h * 128; gate[nt] = 1.0f;
    }
    att::run_attn<2>(lds, c, B.P + hmo(b, 56 + h), qoff, qpos, bits, B.OC, doff, gate, false, nullptr);
}

__device__ __forceinline__ float gelu_tanh(float x) {
    const float u = 0.7978845608028654f * (x + 0.044715f * x * x * x);
    const float e = __expf(2.0f * u);
    const float th = 1.0f - 2.0f / (e + 1.0f);
    return 0.5f * x * (1.0f + th);
}
__device__ __forceinline__ void unit_compress(LAS unsigned char* lds, const Bufs& B, const bf16* W1T, const bf16* W2T, const float* bias, int kv, int rt) {
    const int tid = ltid(), lane = tid & 63, wave = tid >> 6, li = lane & 15, q4 = lane >> 4;
    LAS float* hacc = (LAS float*)lds;
    LAS unsigned char* hb = lds + 131072;
    LAS float* bsum = (LAS float*)(lds + 131072 + 8448);
    __syncthreads();
    if (tid < 256) { float bs = 0.f;
#pragma unroll 8
        for (int kc = 0; kc < 32; ++kc) bs += bias[kc * 256 + tid];
        bsum[tid] = bs; }
    const int rho0 = rt * 32 + li, bg = rho0 >> 7, b = bg >> 1, g = bg & 1;
    const bf16* abase = B.P + hmo(b, (kv ? 10 : 8) + g);
    f32x4 acc[2][16];
#pragma unroll
    for (int tl = 0; tl < 2; ++tl)
#pragma unroll
        for (int nb = 0; nb < 16; ++nb) acc[tl][nb] = (f32x4){0.f, 0.f, 0.f, 0.f};
#pragma unroll 1
    for (int ll = 0; ll < 4; ++ll) {
        const int l = 4 * wave + ll;
        int tok0 = 16 * (rho0 & 127) + l, tok1 = tok0 + 256; tok0 = tok0 > SEQ - 1 ? SEQ - 1 : tok0; tok1 = tok1 > SEQ - 1 ? SEQ - 1 : tok1;
        const bf16* ap0 = abase + tok0 * 128 + q4 * 8;
        const bf16* ap1 = abase + tok1 * 128 + q4 * 8;
        const bf16* bp = W1T + ((size_t)(l * 4) * 16 * 64 + lane) * 8;
#pragma unroll
        for (int ds = 0; ds < 4; ++ds) {
            const bf16x8 af0 = *(const bf16x8*)(ap0 + ds * 32), af1 = *(const bf16x8*)(ap1 + ds * 32);
#pragma unroll
            for (int nb = 0; nb < 16; ++nb) {
                const bf16x8 bfr = *(const bf16x8*)(bp + (size_t)((ds * 16 + nb) * 64) * 8);
                acc[0][nb] = __builtin_amdgcn_mfma_f32_16x16x32_bf16(af0, bfr, acc[0][nb], 0, 0, 0);
                acc[1][nb] = __builtin_amdgcn_mfma_f32_16x16x32_bf16(af1, bfr, acc[1][nb], 0, 0, 0);
            }
        }
    }
    bf16* outp = (kv ? B.VC : B.KC);
#pragma unroll
    for (int tl = 0; tl < 2; ++tl) {
#pragma unroll
        for (int nb = 0; nb < 16; ++nb)
#pragma unroll
            for (int jj = 0; jj < 4; ++jj) hacc[wave * 4096 + (4 * q4 + jj) * 256 + nb * 16 + li] = acc[tl][nb][jj];
        __syncthreads();
        for (int e = tid; e < 4096; e += 512) {
            const int row = e >> 8, f = e & 255;
            float hs = 0.f;
#pragma unroll
            for (int w = 0; w < 8; ++w) hs += hacc[w * 4096 + e];
            const float v = gelu_tanh(hs + bsum[f]);
            *(LAS bf16*)(hb + row * 528 + f * 2) = (bf16)f2bf(v);
        }
        __syncthreads();
        f32x4 o2 = (f32x4){0.f, 0.f, 0.f, 0.f};
#pragma unroll
        for (int ks = 0; ks < 8; ++ks) {
            const bf16x8 af = *(const LAS bf16x8*)(hb + li * 528 + (ks * 32 + q4 * 8) * 2);
            const bf16x8 bfr = *(const bf16x8*)(W2T + (size_t)(wave * 16 + li) * 256 + ks * 32 + q4 * 8);
            o2 = __builtin_amdgcn_mfma_f32_16x16x32_bf16(af, bfr, o2, 0, 0, 0);
        }
#pragma unroll
        for (int jj = 0; jj < 4; ++jj) outp[(size_t)(rt * 32 + tl * 16 + 4 * q4 + jj) * 128 + wave * 16 + li] = (bf16)f2bf(o2[jj]);
        __syncthreads();
    }
}
__device__ __forceinline__ void gate_gemm(const Bufs& B, const bf16* H, const bf16* Wg, const float* ssp, int gwv, int nwv) {
    const int lane = ltid() & 63, li = lane & 15, q4 = lane >> 4;
    for (int rt = gwv; rt < TOK / 16; rt += nwv) {
        const bf16* ap = H + (size_t)(rt * 16 + li) * DM + q4 * 8;
        const bf16* bp = Wg + (size_t)li * DM + q4 * 8;
        f32x4 a0 = (f32x4){0.f, 0.f, 0.f, 0.f}, a1 = a0;
#pragma unroll 8
        for (int ks = 0; ks < DM / 32; ++ks) {
            const bf16x8 af = *(const bf16x8*)(ap + ks * 32);
            const bf16x8 b0 = *(const bf16x8*)(bp + ks * 32), b1 = *(const bf16x8*)(bp + (size_t)16 * DM + ks * 32);
            a0 = __builtin_amdgcn_mfma_f32_16x16x32_bf16(af, b0, a0, 0, 0, 0);
            a1 = __builtin_amdgcn_mfma_f32_16x16x32_bf16(af, b1, a1, 0, 0, 0);
        }
#pragma unroll
        for (int jj = 0; jj < 4; ++jj) {
            bf16* op = B.GM + (size_t)(rt * 16 + 4 * q4 + jj) * GMP + 6144 + li;
            const float rs = pg8::row_rscale(ssp, rt * 16 + 4 * q4 + jj);
            op[0] = (bf16)f2bf(a0[jj] * rs); op[16] = (bf16)f2bf(a1[jj] * rs);
        }
    }
}
__device__ __forceinline__ void unit_kmean(LAS unsigned char* lds, const Bufs& B, int item) {
    const int tid = ltid();
    const int j = item & 7, h = (item >> 3) & 7, b = item >> 6;
    LAS float* red = (LAS float*)lds;
    __syncthreads();
    const int d8 = tid & 15, tg = tid >> 4;
    float a[8];
#pragma unroll
    for (int e = 0; e < 8; ++e) a[e] = 0.f;
#pragma unroll
    for (int i = 0; i < 8; ++i) {
        const int t = 256 * j + tg + 32 * i;
        const v4u w = *(const v4u*)(B.P + hmo(b, 64 + h) + t * 128 + d8 * 8);
        a[0] += pg8::bf_lo(w.x); a[1] += pg8::bf_hi(w.x); a[2] += pg8::bf_lo(w.y); a[3] += pg8::bf_hi(w.y); a[4] += pg8::bf_lo(w.z); a[5] += pg8::bf_hi(w.z); a[6] += pg8::bf_lo(w.w); a[7] += pg8::bf_hi(w.w);
    }
#pragma unroll
    for (int e = 0; e < 8; ++e) red[tg * 128 + d8 * 8 + e] = a[e];
    __syncthreads();
    if (tid < 128) {
        float s = 0.f;
#pragma unroll 8
        for (int i = 0; i < 32; ++i) s += red[i * 128 + tid];
        B.KMEAN[(size_t)item * 128 + tid] = s * (1.0f / 256.0f);
    }
}
__device__ __forceinline__ void phase_dilmerge(const Bufs& B) {
    const int tid = ltid(), lane = tid & 63, wave = tid >> 6;
    const int gw = lbid() * 8 + wave, NGW = gridDim.x * 8;
    const int slot = lane >> 4, d8 = lane & 15;
    for (int row = gw; row < TOK; row += NGW) {
        float ls[3];
#pragma unroll
        for (int g = 0; g < 3; ++g) ls[g] = B.LSE[((size_t)g * TOK + row) * 4 + slot];
        const float mx = fmaxf(ls[0], fmaxf(ls[1], ls[2]));
        float w[3]; float sw = 0.f;
#pragma unroll
        for (int g = 0; g < 3; ++g) { w[g] = __expf(ls[g] - mx); sw += w[g]; }
        const float inv = 1.0f / sw;
        float a[8];
#pragma unroll
        for (int e = 0; e < 8; ++e) a[e] = 0.f;
#pragma unroll
        for (int g = 0; g < 3; ++g) {
            const v4u v = *(const v4u*)(B.OG + ((size_t)g * TOK + row) * 512 + slot * 128 + d8 * 8); const float ww = w[g] * inv;
            a[0] += ww * pg8::bf_lo(v.x); a[1] += ww * pg8::bf_hi(v.x); a[2] += ww * pg8::bf_lo(v.y); a[3] += ww * pg8::bf_hi(v.y);
            a[4] += ww * pg8::bf_lo(v.z); a[5] += ww * pg8::bf_hi(v.z); a[6] += ww * pg8::bf_lo(v.w); a[7] += ww * pg8::bf_hi(v.w);
        }
        v4u o; o.x = pk2(a[0], a[1]); o.y = pk2(a[2], a[3]); o.z = pk2(a[4], a[5]); o.w = pk2(a[6], a[7]);
        *(v4u*)(B.OB + (size_t)row * 2560 + slot * 128 + d8 * 8) = o;
    }
}

#define RLX_AGENT __ATOMIC_RELAXED, __HIP_MEMORY_SCOPE_AGENT
#define XB_TMO      128
#define XB_XCNT(j)  (256  + 64 * (j))
#define XB_XSUB(j)  (1280 + 64 * (j))
#define XB_XGEN(j)  (2304 + 64 * (j))
#define XB_TOP      3328
#define XB_TOPGEN   3392
#define XCD_BAR_WORDS 3456
#define XB_SPIN_CAP (1u << 18)

__device__ __forceinline__ unsigned xb_ld(unsigned* p)              { return __hip_atomic_load(p, __ATOMIC_RELAXED, __HIP_MEMORY_SCOPE_AGENT); }
__device__ __forceinline__ unsigned xb_add(unsigned* p, unsigned v) { return __hip_atomic_fetch_add(p, v, __ATOMIC_RELAXED, __HIP_MEMORY_SCOPE_AGENT); }
__device__ __forceinline__ unsigned xb_xcc_id() { return (unsigned)__builtin_amdgcn_s_getreg((3 << 11) | 20) & 0xFu; }
#define XB_SPIN(cond, bar) do { unsigned _sp = 0; while (cond) { __builtin_amdgcn_s_sleep(1); \
    if ((++_sp & 255u) == 0u) { if (xb_ld(&(bar)[XB_TMO])) break; if (_sp > XB_SPIN_CAP) { atomicAdd(&(bar)[XB_TMO], 1u); break; } } } } while (0)

struct XcdBarrier {
    unsigned* bar; unsigned x;
    volatile LAS unsigned* st;
};

__device__ __forceinline__ XcdBarrier xcd_barrier_post(unsigned* bar, volatile LAS unsigned* st) {
    XcdBarrier b; b.bar = bar; b.x = xb_xcc_id(); b.st = st;
    if (threadIdx.x == 0) (void)xb_add(&bar[XB_XCNT(b.x)], 1u);
    return b;
}
__device__ __forceinline__ void xcd_barrier_complete(unsigned* bar, unsigned x, unsigned& nloc, unsigned& nx) {
    const unsigned G = gridDim.x * gridDim.y * gridDim.z;
    unsigned sum, cnt, mine, sp = 0u;
    for (;;) {
        sum = 0u; cnt = 0u; mine = 0u;
#pragma unroll
        for (unsigned j = 0; j < 16; ++j) { const unsigned c = xb_ld(&bar[XB_XCNT(j)]); sum += c; cnt += (c > 0u) ? 1u : 0u; mine = (j == x) ? c : mine; }
        if (sum == G) break;
        __builtin_amdgcn_s_sleep(1);
        if ((++sp & 255u) == 0u) { if (xb_ld(&bar[XB_TMO])) break; if (sp > XB_SPIN_CAP) { atomicAdd(&bar[XB_TMO], 1u); break; } }
    }
    nloc = mine > 0u ? mine : 1u; nx = cnt > 0u ? cnt : 1u;
}

__device__ __forceinline__ void xcd_barrier(const XcdBarrier& b) {
    asm volatile("s_waitcnt vmcnt(0)" ::: "memory");
    __syncthreads();
    if (threadIdx.x == 0) {
        unsigned* bar = b.bar;
        __builtin_amdgcn_s_waitcnt(0);
        unsigned nloc = b.st[0], nx = b.st[1];
        if (nloc == 0u) { xcd_barrier_complete(bar, b.x, nloc, nx); b.st[0] = nloc; b.st[1] = nx; }
        const unsigned old = xb_add(&bar[XB_XSUB(b.x)], 1u);
        const unsigned gen = old / nloc;
        if (old + 1u == (gen + 1u) * nloc) {
            __builtin_amdgcn_fence(__ATOMIC_RELEASE, "agent");
            asm volatile("s_waitcnt vmcnt(0)" ::: "memory");
            const unsigned og = xb_add(&bar[XB_TOP], 1u);
            const unsigned tg = og / nx;
            if (og + 1u == (tg + 1u) * nx) xb_add(&bar[XB_TOPGEN], 1u);
            else XB_SPIN(xb_ld(&bar[XB_TOPGEN]) == tg, bar);
            __builtin_amdgcn_fence(__ATOMIC_ACQUIRE, "agent");
            xb_add(&bar[XB_XGEN(b.x)], 1u);
            asm volatile("s_waitcnt vmcnt(0)" ::: "memory");
        } else {
            XB_SPIN(xb_ld(&bar[XB_XGEN(b.x)]) == gen, bar);
            __builtin_amdgcn_fence(__ATOMIC_ACQUIRE, "agent");
            asm volatile("s_waitcnt vmcnt(0)" ::: "memory");
        }
    }
    __syncthreads();
}

__device__ __forceinline__ void panel_rscale(LAS float* rst, const float* ssp, int pm) {
    const int tid = ltid(), row = tid >> 1, half = tid & 1;
    const f32x4* pp = (const f32x4*)(ssp + (size_t)(pm * 256 + row) * 32 + half * 16);
    float sacc = 0.f;
#pragma unroll
    for (int i = 0; i < 4; ++i) { const f32x4 v = pp[i]; sacc += (v[0] + v[1]) + (v[2] + v[3]); }
    sacc += __shfl_xor(sacc, 1);
    if (half == 0) rst[row] = rsqrtf(sacc * (1.0f / 2048.0f) + 1e-6f);
    __syncthreads();
}
struct Args { const float* in[17]; float* out; unsigned char* ws; int lo, hi, coop, pad; };
constexpr int NPHASE = 22;

typedef const __attribute__((address_space(4))) Args* KArgs;
__device__ __forceinline__ KArgs kargs() { KArgs p = (KArgs)__builtin_amdgcn_kernarg_segment_ptr(); asm volatile("" : "+s"(p)); return p; }
__device__ __forceinline__ Bufs mk_bufs(unsigned char* ws) {
    Bufs B;
    B.P = (bf16*)(ws + WS_P); B.GM = (bf16*)(ws + WS_GM); B.QR = (bf16*)(ws + WS_QR); B.KC = (bf16*)(ws + WS_KC); B.VC = (bf16*)(ws + WS_VC);
    B.OA = (bf16*)(ws + WS_TMP); B.OC = B.OA + 1536; B.OG = (bf16*)(ws + WS_OG); B.OB = B.OA + 1024;
    B.KMEAN = (float*)(ws + WS_KMEAN); B.LSE = (float*)(ws + WS_LSE); B.SELM = (unsigned*)(ws + WS_SELM);
    return B;
}
__global__ void __launch_bounds__(512, 2) mk_fwd(Args args_unused) {
    extern __shared__ __attribute__((aligned(16))) unsigned char lds_raw[];
    LAS unsigned char* lds = (LAS unsigned char*)lds_raw;
    cg::grid_group grid = cg::this_grid();
    const int lo = kargs()->lo, hi = kargs()->hi, coop = kargs()->coop;
    volatile LAS unsigned* xst = (volatile LAS unsigned*)(lds + LDS_BYTES - 64);
    if (threadIdx.x < 4) xst[threadIdx.x] = 0u;
    __syncthreads();
    XcdBarrier xbar; xbar.bar = (unsigned*)(kargs()->ws + WS_CTL); xbar.x = 0; xbar.st = nullptr;
    if (coop) xbar = xcd_barrier_post((unsigned*)(kargs()->ws + WS_CTL), xst);
    const int G = gridDim.x;
#define IN(k) (lo <= (k) && (k) < hi)
#define SEAM(k) do { if (coop && (k) + 1 < hi) { if (hi > NPHASE) grid.sync(); else xcd_barrier(xbar); } } while (0)

    if (IN(0)) {
        KArgs ka = kargs(); const int bid = lbid(); (void)bid; Ctx C;
#pragma unroll
        for (int i = 0; i < 17; ++i) C.in[i] = ka->in[i];
        C.out = ka->out; C.ws = ka->ws;
        for (int rep_ = 0; rep_ < 1 + (DUPMASK & 1); ++rep_) phase_prep(C, lds, rep_ == 0);
        phase_cast(C.in[0], (bf16*)(C.ws + WS_H), (float*)(C.ws + WS_SSP));
        SEAM(0);
    }

#pragma unroll 1
    for (int l = 0; l < NLAYER; ++l) {
        const int pb = 1 + 10 * l;
        if (IN(pb + 1)) {
          for (int rep_ = 0; rep_ < 1 + ((DUPMASK >> 2) & 1); ++rep_) {
            KArgs ka = kargs(); const int bid = lbid(); (void)bid; unsigned char* ws = ka->ws;
            pg8::Gemm g{(const bf16*)(ws + WS_H), (const bf16*)(ws + WS_WIN) + (size_t)l * PITCH * DM, TOK, 16384, DM}; pg8::StaticOrder S; S.init(TOK, 16384, G, bid);
            const float* ssp_ = (const float*)(ws + WS_SSP) + (size_t)(2 * l) * TOK * 32;
            LAS float* rst = (LAS float*)(lds + 131072 + 1024);
            pg8::Unit u0; const int pm0 = S.next(0, u0) ? u0.pm : 0;
            panel_rscale(rst, ssp_, pm0);
            pg8::EpiInProj E{(bf16*)(ws + WS_P), (bf16*)(ws + WS_QR), (bf16*)(ws + WS_GM), (const float*)(ws + WS_ROPE), rst};
            pg8::gemm_phase<pg8::EpiInProj, pg8::StaticOrder, true, true>(lds, g, S, E);
            }
            SEAM(pb + 1);
        }
        if (IN(pb + 2)) {
          for (int rep_ = 0; rep_ < 1 + ((DUPMASK >> 3) & 1); ++rep_) {
            KArgs ka = kargs(); const int bid = lbid(); (void)bid; unsigned char* ws = ka->ws; const Bufs B = mk_bufs(ws);
            for (int task = bid; task < 64; task += G) {
                const int kv = task & 1, rt = task >> 1;
                unit_compress(lds, B, (const bf16*)(ws + WS_W1T) + (size_t)(l * 2 + kv) * 256 * 4096, (const bf16*)(ws + WS_W2T) + (size_t)(l * 2 + kv) * 128 * 256,
                              (const float*)(ws + WS_BIASP) + (size_t)(l * 2 + kv) * 32 * 256, kv, rt);
            }
            for (int item = (bid + 128) % G; item < 256; item += G) unit_kmean(lds, B, item);
            {
                const int wv = ltid() >> 6, gwv = ((bid + G / 2) % G) * 8 + wv;
                gate_gemm(B, (const bf16*)(ws + WS_H), (const bf16*)(ws + WS_WIN) + (size_t)l * PITCH * DM + (size_t)16384 * DM, (const float*)(ws + WS_SSP) + (size_t)(2 * l) * TOK * 32, gwv, G * 8);
            }
            {
                unsigned* qc = (unsigned*)(ws + WS_QCTR) + 64 * l;
                LAS unsigned* qs = (LAS unsigned*)(lds + LDS_BYTES - 32);
                for (;;) {
                    __syncthreads();
                    if (ltid() == 0) qs[0] = __hip_atomic_fetch_add(qc, 1u, __ATOMIC_RELAXED, __HIP_MEMORY_SCOPE_AGENT);
                    __syncthreads();
                    const int u = (int)qs[0];
                    if (u >= 512) break;
                    if (u < 128) unit_dilated<2>(lds, B, 0, 1, u >> 5, (u >> 3) & 3, 0, (u & 7) * 256);
                    else if (u < 256) { const int v = u - 128; unit_dilated<2>(lds, B, 1, 4, v >> 5, (v >> 3) & 3, (v >> 1) & 3, (v & 1) * 256); }
                    else { const int v = u - 256; unit_dilated<1>(lds, B, 2, 16, v >> 6, (v >> 4) & 3, v & 15, 0); }
                }
            }
            }
            SEAM(pb + 2);
        }
        if (IN(pb + 4)) {
          for (int rep_ = 0; rep_ < 1 + ((DUPMASK >> 5) & 1); ++rep_) {
            { KArgs ka = kargs(); const int bid = lbid(); (void)bid; const Bufs B = mk_bufs(ka->ws);
              for (int u = bid; u < 256; u += G) unit_cmp(lds, B, u); }
            asm volatile("s_waitcnt vmcnt(0)" ::: "memory"); __syncthreads();
            { KArgs ka = kargs(); const int bid = lbid(); (void)bid; const Bufs B = mk_bufs(ka->ws);
              for (int u = bid; u < 256; u += G) unit_nsa(lds, B, u); }
            for (int rep2_ = 0; rep2_ < 1 + ((DUPMASK >> 12) & 1); ++rep2_)
            { KArgs ka = kargs(); const int bid = lbid(); (void)bid; const Bufs B = mk_bufs(ka->ws);
              for (int u = bid; u < 256; u += G) { const int q_blk = u & 31, g = (u >> 5) & 1, b = u >> 6; unit_moba(lds, B, b, (q_blk & 3) * 2 + g, 7 - (q_blk >> 2)); } }
            { KArgs ka = kargs(); const int bid = lbid(); (void)bid; const Bufs B = mk_bufs(ka->ws); phase_dilmerge(B); }
            }
            SEAM(pb + 4);
        }
        if (IN(pb + 5)) {
          for (int rep_ = 0; rep_ < 1 + ((DUPMASK >> 6) & 1); ++rep_) {
            { KArgs ka = kargs(); const int bid = lbid(); unsigned char* ws = ka->ws;
              pg8::StaticOrder S; S.init(TOK, DM, G, bid);
              pg8::Gemm g{(const bf16*)(ws + WS_TMP), (const bf16*)(ws + WS_WBA) + (size_t)l * DM * 2560, TOK, DM, 2560};
              pg8::EpiBranchF E{(const bf16*)(ws + WS_GM), (bf16*)(ws + WS_MG)};
              pg8::gemm_phase<pg8::EpiBranchF, pg8::StaticOrder, true, true>(lds, g, S, E); }
            }
            SEAM(pb + 5);
        }
        if (IN(pb + 6)) {
          for (int rep_ = 0; rep_ < 1 + ((DUPMASK >> 7) & 1); ++rep_) {
            KArgs ka = kargs(); const int bid = lbid(); (void)bid; unsigned char* ws = ka->ws;
            const float* xin = (l == 0) ? ka->in[0] : (const float*)(ws + WS_X2);
            pg8::Gemm g{(const bf16*)(ws + WS_MG), (const bf16*)(ws + WS_WO) + (size_t)l * DM * DM, TOK, DM, DM}; pg8::StaticOrder S; S.init(TOK, DM, G, bid);
            pg8::EpiResid E{xin, (float*)(ws + WS_X1), (bf16*)(ws + WS_H), (float*)(ws + WS_SSP) + (size_t)(2 * l + 1) * TOK * 32};
            pg8::gemm_phase<pg8::EpiResid, pg8::StaticOrder, true, true>(lds, g, S, E);
            }
            SEAM(pb + 6);
        }
        if (IN(pb + 8)) {
          for (int rep_ = 0; rep_ < 1 + ((DUPMASK >> 9) & 1); ++rep_) {
            KArgs ka = kargs(); const int bid = lbid(); (void)bid; unsigned char* ws = ka->ws;
            pg8::Gemm g{(const bf16*)(ws + WS_H), (const bf16*)(ws + WS_WMI) + (size_t)l * DFF * DM, TOK, DFF, DM}; pg8::StaticOrder S; S.init(TOK, DFF, G, bid);
            const float* ssp_ = (const float*)(ws + WS_SSP) + (size_t)(2 * l + 1) * TOK * 32;
            LAS float* rst = (LAS float*)(lds + 131072 + 1024);
            pg8::Unit u0; const int pm0 = S.next(0, u0) ? u0.pm : 0;
            panel_rscale(rst, ssp_, pm0);
            pg8::EpiRelu2 E{(bf16*)(ws + WS_U), rst};
            pg8::gemm_phase<pg8::EpiRelu2, pg8::StaticOrder, true, true>(lds, g, S, E);
            }
            SEAM(pb + 8);
        }
        if (IN(pb + 9)) {
          for (int rep_ = 0; rep_ < 1 + ((DUPMASK >> 10) & 1); ++rep_) {
            KArgs ka = kargs(); const int bid = lbid(); (void)bid; unsigned char* ws = ka->ws;
            pg8::Gemm g{(const bf16*)(ws + WS_U), (const bf16*)(ws + WS_WMO) + (size_t)l * DM * DFF, TOK, DM, DFF}; pg8::StaticOrder S; S.init(TOK, DM, G, bid);
            pg8::EpiResid E{(const float*)(ws + WS_X1), (float*)(ws + WS_X2), (bf16*)(ws + WS_H), (float*)(ws + WS_SSP) + (size_t)(2 * l + 2) * TOK * 32};
            pg8::gemm_phase<pg8::EpiResid, pg8::StaticOrder, true, true>(lds, g, S, E);
            }
            SEAM(pb + 9);
        }
    }
    if (IN(21)) { KArgs ka = kargs(); const int bid = lbid(); (void)bid; phase_final((const float*)(ka->ws + WS_X2), ka->in[16], (const float*)(ka->ws + WS_SSP) + (size_t)4 * TOK * 32, ka->out); }
#undef IN
#undef SEAM
}

#ifndef DUPMASK
#define DUPMASK 0
#endif
#ifndef MK_RUN_PHASES
#define MK_RUN_PHASES NPHASE
#endif
#ifndef MK_MULTI
#define MK_MULTI 0
#endif
extern "C" void kernel_launch(void* const* d_in, const int* in_sizes, int n_in, void* d_out, int out_size, void* d_ws, size_t ws_size, hipStream_t stream) {
    static int grid = 0;
    if (grid == 0) {
        if (n_in != 17 || out_size != TOK * DM || ws_size < WS_END) { fprintf(stderr, "kernel_launch: unexpected shapes (n_in %d out %d ws %zu need %zu)\n", n_in, out_size, ws_size, (size_t)WS_END); grid = -1; return; }
        int dev = 0, cus = 0, per_cu = 0;
        hipGetDevice(&dev); hipDeviceGetAttribute(&cus, hipDeviceAttributeMultiprocessorCount, dev);
        if (hipFuncSetAttribute((const void*)mk_fwd, hipFuncAttributeMaxDynamicSharedMemorySize, LDS_BYTES) != hipSuccess) { fprintf(stderr, "kernel_launch: hipFuncSetAttribute failed\n"); grid = -1; return; }
        hipOccupancyMaxActiveBlocksPerMultiprocessor(&per_cu, (const void*)mk_fwd, 512, LDS_BYTES);
        (void)hipGetLastError();
        if (per_cu < 1) per_cu = 1;
        grid = cus * 1;
        if (grid != 256) { fprintf(stderr, "kernel_launch: this kernel assumes a 256-CU device (got %d)\n", cus); grid = 256; }
    }
    if (grid < 0) return;
    hipMemsetAsync((char*)d_ws, 0, 131072, stream);
    Args a{};
    for (int i = 0; i < 17; ++i) a.in[i] = (const float*)d_in[i];
    a.out = (float*)d_out; a.ws = (unsigned char*)d_ws;
#if MK_MULTI
    for (int p = 0; p < MK_RUN_PHASES; ++p) {
        a.lo = p; a.hi = p + 1; a.coop = 0;
        hipLaunchKernelGGL(mk_fwd, dim3(grid), dim3(512), LDS_BYTES, stream, a);
    }
#else
    a.lo = 0; a.hi = NPHASE; a.coop = 1;
    void* kargs[] = {&a};
    hipError_t e = hipLaunchCooperativeKernel((const void*)mk_fwd, dim3(grid), dim3(512), kargs, LDS_BYTES, stream);
    if (e != hipSuccess) fprintf(stderr, "cooperative launch failed: %s (grid %d)\n", hipGetErrorString(e), grid);
#endif
}
```

```cpp
#include <hip/hip_runtime.h>
#include <hip/hip_cooperative_groups.h>
#include <cstdio>
#include <cstdint>
namespace cg = cooperative_groups;
namespace pg8 {
#define PG8_LAS __attribute__((address_space(3)))
typedef unsigned short bf16_t;
typedef short bf16x8 __attribute__((ext_vector_type(8)));
typedef float f32x4 __attribute__((ext_vector_type(4)));
typedef unsigned u32x4 __attribute__((ext_vector_type(4)));
constexpr int BM = 256, BK = 64, HALF = 128, HTB = HALF * BK * 2  , STAGE_BYTES = 8 * HTB, NXCD = 8, WGM = 4;

__host__ __device__ __forceinline__ int lds_byte(int r, int c) { const int st = (r >> 4) * 2 + (c >> 5), rr = r & 15, cc = c & 31, ob = rr * 64 + cc * 2; return st * 1024 + (ob ^ (((ob >> 9) & 1) << 5)); }
__host__ __device__ __forceinline__ void stage_rc(int b, int& R, int& C) { const int st = b / 1024, sb = b % 1024, swz = sb ^ (((sb >> 9) & 1) << 5); R = (st >> 1) * 16 + swz / 64; C = (st & 1) * 32 + (swz % 64) / 2; }
__host__ __device__ __forceinline__ int perm32(int rho) { const int n = rho >> 4, i = rho & 15; return 8 * (i >> 2) + 4 * n + (i & 3); }

struct Unit { int pm, pn; };
struct Gemm { const bf16_t* A; const bf16_t* Bt; int M, N, K; };

struct StaticOrder {
    int nM, nN, nwg, G, c;
    __host__ __device__ void init(int M, int N, int G_, int c_) { nM = M / BM; nN = N / BM; nwg = nM * nN; G = G_; c = c_; }
    __host__ __device__ __forceinline__ bool next(int i, Unit& u) const {
        const long L = (long)i * G + c; if (L >= nwg) return false;
        int wgid = (int)L; { const int q = nwg / NXCD, r = nwg % NXCD, xcd = wgid % NXCD, off = wgid / NXCD; wgid = (xcd < r ? xcd * (q + 1) : r * (q + 1) + (xcd - r) * q) + off; }
        const int nig = WGM * nN, gid = wgid / nig, fm = gid * WGM, gsz = (nM - fm) < WGM ? (nM - fm) : WGM;
        u.pm = fm + ((wgid % nig) % gsz); u.pn = (wgid % nig) / gsz; return true;
    }
    __device__ __forceinline__ void a_ready(const Unit&) const {}
    __device__ __forceinline__ void done(const Unit&) const {}
};


__device__ __forceinline__ unsigned cvt_pk_bf16(float lo, float hi) { unsigned r; asm volatile("v_cvt_pk_bf16_f32 %0, %1, %2" : "=v"(r) : "v"(lo), "v"(hi)); return r; }
typedef unsigned u32x2 __attribute__((ext_vector_type(2)));
__device__ __forceinline__ float bf_lo(unsigned w) { return __uint_as_float(w << 16); }
__device__ __forceinline__ float bf_hi(unsigned w) { return __uint_as_float(w & 0xffff0000u); }
__device__ __forceinline__ float sigmoidf_(float x) { return 1.0f / (1.0f + __expf(-x)); }
__device__ __forceinline__ void store8bf(bf16_t* p, f32x4 v0, f32x4 v1) {
    u32x4 w; w.x = cvt_pk_bf16(v0[0], v0[1]); w.y = cvt_pk_bf16(v0[2], v0[3]); w.z = cvt_pk_bf16(v1[0], v1[1]); w.w = cvt_pk_bf16(v1[2], v1[3]);
    *(u32x4*)p = w;
}

constexpr int IP_PITCH = 16640, GM_PITCH = 6400, NHM = 80;
__device__ __forceinline__ float row_rscale(const float* ssp, int row) {
    const f32x4* pp = (const f32x4*)(ssp + (size_t)row * 32);
    float s = 0.f;
#pragma unroll
    for (int i = 0; i < 8; ++i) { const f32x4 v = pp[i]; s += (v[0] + v[1]) + (v[2] + v[3]); }
    return rsqrtf(s * (1.0f / 2048.0f) + 1e-6f);
}
struct EpiInProj {
    static constexpr bool HAS_MID = false; static constexpr int T1 = -1, T2 = -1; static constexpr bool PERM = true, AFTER_DRAIN = false;
    bf16_t* HM; bf16_t* QR; bf16_t* GM; const float* rope; const PG8_LAS float* rst;
    __device__ __forceinline__ void operator()(const f32x4 (&acc)[2][2][4][2], const Unit& u, int wr, int wc, int fr, int fq) const {
        const int row0 = u.pm * BM + wr * 64 + fr;
#pragma unroll
        for (int bj = 0; bj < 2; ++bj) {
            const int cb = u.pn * BM + bj * HALF;
            const bool isq = cb < 1024, ishm = cb < 10240;
            const bool rope_seg = isq || (cb >= 1536 && cb < 1792) || (cb >= 2048 && cb < 2304) || (cb >= 2560 && cb < 5632) || (cb >= 7168 && cb < 9216);
            const bool rot = rope_seg && (wc == 0);
            const int hidx = cb >> 7, cin = wc * 32 + 8 * fq;
#pragma unroll
            for (int ai = 0; ai < 2; ++ai)
#pragma unroll
                for (int m = 0; m < 4; ++m) {
                    const int row = row0 + ai * HALF + m * 16, b = row >> 11, t = row & 2047;
                    const float rs = rst[wr * 64 + fr + ai * HALF + m * 16];
                    f32x4 v0 = acc[ai][bj][m][0] * rs, v1 = acc[ai][bj][m][1] * rs;
                    bf16_t* hp = HM + ((((size_t)(b * NHM + hidx)) * 2048 + t) << 7) + cin;
                    if (isq) store8bf(hp, v0, v1);
                    if (rot) {
                        const f32x4 k0 = (fq & 1) ? (f32x4){0.00022507907903927653f, 9.911730936901935e-05f, 4.364795279280289e-05f, 1.9221100684944863e-05f} : (f32x4){0.15915494309189535f, 0.0700865215877985f, 0.03086376340470123f, 0.013591370636193905f};
                        const f32x4 k1 = (fq & 1) ? (f32x4){8.464330808241401e-06f, 3.727408601915352e-06f, 1.6414262627950345e-06f, 7.228293068832865e-07f} : (f32x4){0.005985185712713705f, 0.002635675898667414f, 0.001160663641240061f, 0.0005111175045375439f};
                        const float tf = (float)t;
                        f32x4 c0, c1, s0, s1;
#pragma unroll
                        for (int e = 0; e < 4; ++e) {
                            const float r0 = __builtin_amdgcn_fractf(tf * k0[e]), r1 = __builtin_amdgcn_fractf(tf * k1[e]);
                            c0[e] = __builtin_amdgcn_cosf(r0); s0[e] = __builtin_amdgcn_sinf(r0); c1[e] = __builtin_amdgcn_cosf(r1); s1[e] = __builtin_amdgcn_sinf(r1);
                        }
                        f32x4 p0, p1;
#pragma unroll
                        for (int e = 0; e < 4; ++e) { p0[e] = __shfl_xor(v0[e], 32); p1[e] = __shfl_xor(v1[e], 32); }
                        const float sg = (fq < 2) ? -1.0f : 1.0f;
                        v0 = v0 * c0 + (p0 * s0) * sg; v1 = v1 * c1 + (p1 * s1) * sg;
                    }
                    bf16_t* dst = isq ? (QR + ((((size_t)(b * 8 + hidx)) * 2048 + t) << 7) + cin) : (ishm ? hp : (GM + (size_t)row * GM_PITCH + (cb - 10240) + cin));
                    store8bf(dst, v0, v1);
                }
        }
    }
};
template <int MODE> struct EpiBranch {
    static constexpr bool HAS_MID = false; static constexpr int T1 = -1, T2 = -1; static constexpr bool PERM = false, AFTER_DRAIN = false;
    const bf16_t* GM; int gcol; float* TMP; bf16_t* MG;
    __device__ __forceinline__ void operator()(const f32x4 (&acc)[2][2][4][2], const Unit& u, int wr, int wc, int fr, int fq) const {
        const int row0 = u.pm * BM + wr * 64 + fr, col0 = u.pn * BM + wc * 32 + 4 * fq;
#pragma unroll
        for (int ai = 0; ai < 2; ++ai)
#pragma unroll
            for (int m = 0; m < 4; ++m) {
                const int row = row0 + ai * HALF + m * 16;
#pragma unroll
                for (int bj = 0; bj < 2; ++bj)
#pragma unroll
                    for (int n = 0; n < 2; ++n) {
                        const int col = col0 + bj * HALF + n * 16;
                        const u32x2 mr = *(const u32x2*)(GM + (size_t)row * GM_PITCH + gcol + col);
                        f32x4 sg; sg[0] = sigmoidf_(bf_lo(mr.x)); sg[1] = sigmoidf_(bf_hi(mr.x)); sg[2] = sigmoidf_(bf_lo(mr.y)); sg[3] = sigmoidf_(bf_hi(mr.y));
                        f32x4 val = acc[ai][bj][m][n] * sg;
                        float* tp = TMP + (size_t)row * 2048 + col;
                        if (MODE == 0) { *(f32x4*)tp = val; }
                        else if (MODE == 1) { *(f32x4*)tp = *(const f32x4*)tp + val; }
                        else { val = val + *(const f32x4*)tp; u32x2 w; w.x = cvt_pk_bf16(val[0], val[1]); w.y = cvt_pk_bf16(val[2], val[3]); *(u32x2*)(MG + (size_t)row * 2048 + col) = w; }
                    }
                asm volatile("" ::: "memory");
            }
    }
};
struct EpiBranchF {
    static constexpr bool HAS_MID = true; static constexpr int T1 = 16, T2 = 24; static constexpr bool PERM = false, AFTER_DRAIN = false;
    const bf16_t* GM; bf16_t* MG;
    __device__ __forceinline__ void mid(f32x4 (&acc)[2][2][4][2], const Unit& u, int t, int wr, int wc, int fr, int fq) const {
        const int gx = (t == T1) ? 0 : 2048;
        int fr_ = fr, fq_ = fq; asm volatile("" : "+v"(fr_), "+v"(fq_));
        const int row0 = u.pm * BM + wr * 64 + fr_, col0 = u.pn * BM + wc * 32 + 4 * fq_;
#pragma unroll
        for (int ai = 0; ai < 2; ++ai)
#pragma unroll
            for (int m = 0; m < 4; ++m) {
                const bf16_t* gp = GM + (size_t)(row0 + ai * HALF + m * 16) * GM_PITCH + gx + col0;
#pragma unroll
                for (int bj = 0; bj < 2; ++bj)
#pragma unroll
                    for (int n = 0; n < 2; ++n) {
                        const u32x2 mx = *(const u32x2*)(gp + bj * HALF + n * 16), my = *(const u32x2*)(gp + 2048 + bj * HALF + n * 16);
                        f32x4 r;
                        r[0] = (1.0f + __expf(-bf_lo(my.x))) * __builtin_amdgcn_rcpf(1.0f + __expf(-bf_lo(mx.x))); r[1] = (1.0f + __expf(-bf_hi(my.x))) * __builtin_amdgcn_rcpf(1.0f + __expf(-bf_hi(mx.x)));
                        r[2] = (1.0f + __expf(-bf_lo(my.y))) * __builtin_amdgcn_rcpf(1.0f + __expf(-bf_lo(mx.y))); r[3] = (1.0f + __expf(-bf_hi(my.y))) * __builtin_amdgcn_rcpf(1.0f + __expf(-bf_hi(mx.y)));
                        acc[ai][bj][m][n] = acc[ai][bj][m][n] * r;
                        if (n == 1) asm volatile("" ::: "memory");
                    }
            }
    }
    __device__ __forceinline__ void operator()(const f32x4 (&acc)[2][2][4][2], const Unit& u, int wr, int wc, int fr, int fq) const {
        const int row0 = u.pm * BM + wr * 64 + fr, col0 = u.pn * BM + wc * 32 + 4 * fq;
#pragma unroll
        for (int ai = 0; ai < 2; ++ai)
#pragma unroll
            for (int m = 0; m < 4; ++m) {
                const int row = row0 + ai * HALF + m * 16;
#pragma unroll
                for (int bj = 0; bj < 2; ++bj)
#pragma unroll
                    for (int n = 0; n < 2; ++n) {
                        const int col = col0 + bj * HALF + n * 16;
                        const u32x2 mr = *(const u32x2*)(GM + (size_t)row * GM_PITCH + 4096 + col);
                        f32x4 sg; sg[0] = sigmoidf_(bf_lo(mr.x)); sg[1] = sigmoidf_(bf_hi(mr.x)); sg[2] = sigmoidf_(bf_lo(mr.y)); sg[3] = sigmoidf_(bf_hi(mr.y));
                        const f32x4 val = acc[ai][bj][m][n] * sg;
                        u32x2 w; w.x = cvt_pk_bf16(val[0], val[1]); w.y = cvt_pk_bf16(val[2], val[3]); *(u32x2*)(MG + (size_t)row * 2048 + col) = w;
                    }
                if (m & 1) asm volatile("" ::: "memory");
            }
    }
};
struct EpiResid {
    static constexpr bool HAS_MID = false; static constexpr int T1 = -1, T2 = -1; static constexpr bool PERM = false, AFTER_DRAIN = false;
    const float* base; float* out; bf16_t* xb; float* ssp;
    __device__ __forceinline__ void operator()(const f32x4 (&acc)[2][2][4][2], const Unit& u, int wr, int wc, int fr, int fq) const {
        const int row0 = u.pm * BM + wr * 64 + fr, col0 = u.pn * BM + wc * 32 + 4 * fq;
#pragma unroll
        for (int ai = 0; ai < 2; ++ai)
#pragma unroll
            for (int m = 0; m < 4; ++m) {
                const int row = row0 + ai * HALF + m * 16;
                const size_t off = (size_t)row * 2048 + col0;
                float ss = 0.f;
#pragma unroll
                for (int bj = 0; bj < 2; ++bj)
#pragma unroll
                    for (int n = 0; n < 2; ++n) {
                        const size_t o2 = off + bj * HALF + n * 16; const f32x4 v = *(const f32x4*)(base + o2) + acc[ai][bj][m][n];
                        *(f32x4*)(out + o2) = v; ss += (v[0] * v[0] + v[1] * v[1]) + (v[2] * v[2] + v[3] * v[3]);
                        u32x2 w; w.x = cvt_pk_bf16(v[0], v[1]); w.y = cvt_pk_bf16(v[2], v[3]); *(u32x2*)(xb + o2) = w;
                    }
                ss += __shfl_xor(ss, 16); ss += __shfl_xor(ss, 32);
                if (fq == 0) ssp[(size_t)row * 32 + u.pn * 4 + wc] = ss;
                asm volatile("" ::: "memory");
            }
    }
};
struct EpiRelu2 {
    static constexpr bool HAS_MID = false; static constexpr int T1 = -1, T2 = -1; static constexpr bool PERM = true, AFTER_DRAIN = false;
    bf16_t* U; const PG8_LAS float* rst;
    __device__ __forceinline__ void operator()(const f32x4 (&acc)[2][2][4][2], const Unit& u, int wr, int wc, int fr, int fq) const {
        const int row0 = u.pm * BM + wr * 64 + fr, col0 = u.pn * BM + wc * 32 + 8 * fq;
#pragma unroll
        for (int ai = 0; ai < 2; ++ai)
#pragma unroll
            for (int m = 0; m < 4; ++m) {
                bf16_t* rowp = U + (size_t)(row0 + ai * HALF + m * 16) * 8192 + col0;
                const float rs = rst[wr * 64 + fr + ai * HALF + m * 16];
#pragma unroll
                for (int bj = 0; bj < 2; ++bj) {
                    f32x4 v0 = acc[ai][bj][m][0], v1 = acc[ai][bj][m][1];
#pragma unroll
                    for (int e = 0; e < 4; ++e) { const float a = fmaxf(v0[e], 0.f) * rs, b = fmaxf(v1[e], 0.f) * rs; v0[e] = a * a; v1[e] = b * b; }
                    store8bf(rowp + bj * HALF, v0, v1);
                }
            }
    }
};

template <class Epi, class Sched, bool ALIGN_EPI = false, bool SP2 = false>
__device__ __forceinline__ void gemm_phase(PG8_LAS unsigned char* lds, const Gemm g, const Sched& S, const Epi& E) {
    int tid_ = threadIdx.x; asm volatile("" : "+v"(tid_)); const int tid = tid_, wid = __builtin_amdgcn_readfirstlane(tid >> 6), lane = tid & 63, wr = wid >> 2, wc = wid & 3, fr = lane & 15, fq = lane >> 4;
    const int K = g.K, nt = K / BK;
    unsigned voffA[2], voffB[2];
#pragma unroll
    for (int i = 0; i < 2; ++i) { int R, C; stage_rc(tid * 16 + i * 8192, R, C); const int Rb = Epi::PERM ? ((R & ~31) + perm32(R & 31)) : R;
        voffA[i] = (unsigned)(R * K + C) * 2u; voffB[i] = (unsigned)(Rb * K + C) * 2u; }
    const size_t kstep = (size_t)(BK * 2);
    const size_t hstep = (size_t)HALF * K * 2;
    const size_t tstep = 2 * hstep;
    const unsigned ldsw = (unsigned)wid * 1024u;
    const int aoff = lds_byte(wr * 64 + fr, fq * 8), boff = lds_byte(wc * 32 + fr, fq * 8);
#define PG8_SA(b, h) (((b) * 2 + (h)) * HTB)
#define PG8_SB(b, h) ((4 + (b) * 2 + (h)) * HTB)
#define PG8_STAGE(bufoff, gbase, voff) do { _Pragma("unroll") for (int _i = 0; _i < 2; ++_i) \
        __builtin_amdgcn_global_load_lds((const unsigned*)((const char*)(gbase) + (voff)[_i]), (PG8_LAS unsigned*)(lds + (bufoff) + ldsw + _i * 8192), 16, 0, 0); } while (0)
#define PG8_LDA(dst, b, h) do { _Pragma("unroll") for (int m = 0; m < 4; ++m) _Pragma("unroll") for (int k = 0; k < 2; ++k) dst[m][k] = *(const PG8_LAS bf16x8*)(lds + PG8_SA(b, h) + aoff + m * 2048 + k * 1024); } while (0)
#define PG8_LDB(dst, b, h) do { _Pragma("unroll") for (int n = 0; n < 2; ++n) _Pragma("unroll") for (int k = 0; k < 2; ++k) dst[n][k] = *(const PG8_LAS bf16x8*)(lds + PG8_SB(b, h) + boff + n * 2048 + k * 1024); } while (0)
#define PG8_MMA(ai, bj, At, Bt) do { __builtin_amdgcn_s_setprio(1); _Pragma("unroll") for (int m = 0; m < 4; ++m) _Pragma("unroll") for (int n = 0; n < 2; ++n) _Pragma("unroll") for (int k = 0; k < 2; ++k) \
        acc[ai][bj][m][n] = __builtin_amdgcn_mfma_f32_16x16x32_bf16(Bt[n][k], At[m][k], acc[ai][bj][m][n], 0, 0, 0); __builtin_amdgcn_s_setprio(0); } while (0)
#define PG8_WAIT_V(n) asm volatile("s_waitcnt vmcnt(" #n ")" ::: "memory")
#define PG8_WAIT_L(n) asm volatile("s_waitcnt lgkmcnt(" #n ")" ::: "memory")
#define PG8_BAR __builtin_amdgcn_s_barrier()
#define PG8_SCHED __builtin_amdgcn_sched_barrier(0)
    Unit cur, nxt; int ui = 0;
    if (!S.next(0, cur)) return;
    f32x4 acc[2][2][4][2];
#pragma unroll
    for (int a = 0; a < 2; ++a)
#pragma unroll
        for (int b = 0; b < 2; ++b)
#pragma unroll
            for (int m = 0; m < 4; ++m)
#pragma unroll
                for (int n = 0; n < 2; ++n) acc[a][b][m][n] = (f32x4){0.f, 0.f, 0.f, 0.f};
    bf16x8 At[4][2], B0[2][2], B1[2][2];
    const char* cA = (const char*)g.A + (size_t)cur.pm * tstep; const char* cB = (const char*)g.Bt + (size_t)cur.pn * tstep;
    S.a_ready(cur);
    if constexpr (SP2) {
        PG8_STAGE(PG8_SB(0, 0), cB, voffB); PG8_STAGE(PG8_SB(0, 1), cB + hstep, voffB); PG8_STAGE(PG8_SA(0, 0), cA, voffA); PG8_STAGE(PG8_SA(0, 1), cA + hstep, voffA);
        if (wr == 1) PG8_BAR;
        PG8_WAIT_V(2); PG8_BAR;
        PG8_STAGE(PG8_SB(1, 0), cB + kstep, voffB); PG8_STAGE(PG8_SA(1, 0), cA + kstep, voffA); PG8_STAGE(PG8_SB(1, 1), cB + hstep + kstep, voffB);
        PG8_WAIT_V(6); PG8_BAR;
    } else {
        PG8_STAGE(PG8_SB(0, 0), cB, voffB); PG8_STAGE(PG8_SA(0, 0), cA, voffA); PG8_STAGE(PG8_SB(0, 1), cB + hstep, voffB); PG8_STAGE(PG8_SA(0, 1), cA + hstep, voffA);
        if (wr == 1) PG8_BAR;
        PG8_WAIT_V(4); PG8_BAR;
        PG8_STAGE(PG8_SB(1, 0), cB + kstep, voffB); PG8_STAGE(PG8_SA(1, 0), cA + kstep, voffA); PG8_STAGE(PG8_SB(1, 1), cB + hstep + kstep, voffB);
        PG8_WAIT_V(6); PG8_BAR;
    }
    for (;;) {
        const bool has_next = S.next(ui + 1, nxt);
        const char* nA = has_next ? (const char*)g.A + (size_t)nxt.pm * tstep : cA; const char* nB = has_next ? (const char*)g.Bt + (size_t)nxt.pn * tstep : cB;
        for (int t = 0; t < nt; t += 2) {
            if constexpr (Epi::HAS_MID) { if (t == Epi::T1 || t == Epi::T2) E.mid(acc, cur, t, wr, wc, fr, fq); }
            const bool last = (t == nt - 2);
            const char* a1 = cA + (size_t)(t + 1) * kstep;
            const char* a2 = last ? nA : cA + (size_t)(t + 2) * kstep; const char* b2 = last ? nB : cB + (size_t)(t + 2) * kstep;
            const char* a3 = a2 + kstep; const char* b3 = b2 + kstep;
            if (last && has_next) S.a_ready(nxt);
            if constexpr (SP2) {
            PG8_LDB(B0, 0, 0); PG8_LDB(B1, 0, 1); PG8_SCHED; PG8_LDA(At, 0, 0); PG8_STAGE(PG8_SA(1, 1), a1 + hstep, voffA);
            PG8_WAIT_V(8); PG8_WAIT_L(0); PG8_BAR; PG8_MMA(0, 0, At, B0); PG8_MMA(0, 1, At, B1); PG8_BAR; PG8_SCHED;
            PG8_LDA(At, 0, 1); PG8_STAGE(PG8_SB(0, 0), b2, voffB); PG8_STAGE(PG8_SB(0, 1), b2 + hstep, voffB); PG8_STAGE(PG8_SA(0, 0), a2, voffA);
            PG8_WAIT_V(8); PG8_WAIT_L(0); PG8_BAR; PG8_MMA(1, 0, At, B0); PG8_MMA(1, 1, At, B1); PG8_BAR; PG8_SCHED;
            PG8_LDB(B0, 1, 0); PG8_LDB(B1, 1, 1); PG8_SCHED; PG8_LDA(At, 1, 0); PG8_STAGE(PG8_SA(0, 1), a2 + hstep, voffA);
            PG8_WAIT_V(8); PG8_WAIT_L(0); PG8_BAR; PG8_MMA(0, 0, At, B0); PG8_MMA(0, 1, At, B1); PG8_BAR; PG8_SCHED;
            PG8_LDA(At, 1, 1); PG8_STAGE(PG8_SB(1, 0), b3, voffB); PG8_STAGE(PG8_SB(1, 1), b3 + hstep, voffB); PG8_STAGE(PG8_SA(1, 0), a3, voffA);
            PG8_WAIT_V(8); PG8_WAIT_L(0); PG8_BAR; PG8_MMA(1, 0, At, B0); PG8_MMA(1, 1, At, B1); PG8_BAR; PG8_SCHED;
            } else {
            PG8_LDB(B0, 0, 0); PG8_SCHED; PG8_LDA(At, 0, 0); PG8_STAGE(PG8_SA(1, 1), a1 + hstep, voffA);
            PG8_WAIT_L(8); PG8_BAR; PG8_WAIT_L(0); PG8_MMA(0, 0, At, B0); PG8_BAR; PG8_SCHED;
            PG8_LDB(B1, 0, 1); PG8_STAGE(PG8_SB(0, 0), b2, voffB);
            PG8_BAR; PG8_WAIT_L(0); PG8_MMA(0, 1, At, B1); PG8_BAR;
            PG8_LDA(At, 0, 1); PG8_STAGE(PG8_SA(0, 0), a2, voffA);
            PG8_BAR; PG8_WAIT_L(0); PG8_MMA(1, 0, At, B0); PG8_BAR; PG8_SCHED;
            PG8_STAGE(PG8_SB(0, 1), b2 + hstep, voffB);
            PG8_WAIT_V(6); PG8_BAR; PG8_MMA(1, 1, At, B1); PG8_BAR;
            PG8_LDB(B0, 1, 0); PG8_SCHED; PG8_LDA(At, 1, 0); PG8_STAGE(PG8_SA(0, 1), a2 + hstep, voffA);
            PG8_WAIT_L(8); PG8_BAR; PG8_WAIT_L(0); PG8_MMA(0, 0, At, B0); PG8_BAR; PG8_SCHED;
            PG8_LDB(B1, 1, 1); PG8_STAGE(PG8_SB(1, 0), b3, voffB);
            PG8_BAR; PG8_WAIT_L(0); PG8_MMA(0, 1, At, B1); PG8_BAR;
            PG8_LDA(At, 1, 1); PG8_STAGE(PG8_SA(1, 0), a3, voffA);
            PG8_BAR; PG8_WAIT_L(0); PG8_MMA(1, 0, At, B0); PG8_BAR; PG8_SCHED;
            PG8_STAGE(PG8_SB(1, 1), b3 + hstep, voffB);
            PG8_WAIT_V(6); PG8_BAR; PG8_MMA(1, 1, At, B1); PG8_BAR;
            }
        }
        if constexpr (ALIGN_EPI) { if (wr == 0) PG8_BAR; }
        if constexpr (!Epi::AFTER_DRAIN) { E(acc, cur, wr, wc, fr, fq); S.done(cur); }
        if (!has_next) break;
#pragma unroll
        for (int a = 0; a < 2; ++a)
#pragma unroll
            for (int b = 0; b < 2; ++b)
#pragma unroll
                for (int m = 0; m < 4; ++m)
#pragma unroll
                    for (int n = 0; n < 2; ++n) acc[a][b][m][n] = (f32x4){0.f, 0.f, 0.f, 0.f};
        cur = nxt; cA = nA; cB = nB; ++ui;
        if constexpr (ALIGN_EPI) { if (wr == 1) PG8_BAR; }
    }
    PG8_WAIT_V(0);
    if constexpr (!ALIGN_EPI) { if (wr == 0) PG8_BAR; }
    PG8_BAR;
    if constexpr (Epi::AFTER_DRAIN) { E.fused(acc, cur, wr, wc, fr, fq, lds, wid, lane); S.done(cur); }
#undef PG8_SA
#undef PG8_SB
#undef PG8_STAGE
#undef PG8_LDA
#undef PG8_LDB
#undef PG8_MMA
#undef PG8_WAIT_V
#undef PG8_WAIT_L
#undef PG8_BAR
#undef PG8_SCHED
}
}
#ifndef DUPMASK
#define DUPMASK 0
#endif

#define LAS __attribute__((address_space(3)))
typedef unsigned short bf16;
typedef unsigned v4u __attribute__((ext_vector_type(4)));
typedef unsigned v2u __attribute__((ext_vector_type(2)));
typedef float f32x4 __attribute__((ext_vector_type(4)));
typedef short bf16x8 __attribute__((ext_vector_type(8)));
typedef short s16x4 __attribute__((ext_vector_type(4)));

constexpr int DM = 2048, NB = 4, SEQ = 2048, TOK = NB * SEQ, DFF = 8192, PITCH = 16640, NLAYER = 2;
constexpr int COL_AQ = 0, COL_AKC = 1024, COL_AVC = 1280, COL_AKS = 1536, COL_AVS = 1792, COL_AKW = 2048, COL_AVW = 2304,
              COL_BQ = 2560, COL_BK = 4096, COL_BV = 5632, COL_CQ = 7168, COL_CK = 8192, COL_CV = 9216,
              COL_MA = 10240, COL_MB = 12288, COL_MC = 14336, COL_AG = 16384;
constexpr int IN_W = 16408, GMP = 6400;
__device__ __forceinline__ size_t hmo(int b, int hidx) { return ((size_t)(b * 80 + hidx) * 2048) << 7; }
static_assert(PITCH == pg8::IP_PITCH, "pitch");

constexpr size_t MiB = 1u << 20;
constexpr size_t WS_QCTR = 32768;
constexpr size_t WS_CTL = 65536;
constexpr size_t WS_BIAS = 0;
constexpr size_t WS_ROPE = 1 * MiB;
constexpr size_t WS_BIASP = WS_ROPE + 512 * 1024;
constexpr size_t WS_WIN = 2 * MiB;
constexpr size_t WS_WMI = WS_WIN + 130 * MiB;
constexpr size_t WS_WMO = WS_WMI + 64 * MiB;
constexpr size_t WS_WO = WS_WMO + 64 * MiB;
constexpr size_t WS_WBA = WS_WO + 16 * MiB;
constexpr size_t WS_WBB = WS_WBA + 8 * MiB;
constexpr size_t WS_WBC = WS_WBB + 4 * MiB;
constexpr size_t WS_W1T = WS_WBC + 8 * MiB;
constexpr size_t WS_W2T = WS_W1T + 8 * MiB;
constexpr size_t WS_H = WS_W2T + 1 * MiB;
constexpr size_t WS_P = WS_H + 32 * MiB;
constexpr size_t WS_GM = WS_P + 160 * MiB;
constexpr size_t WS_QR = WS_P + 260 * MiB;
constexpr size_t WS_KC = WS_QR + 16 * MiB;
constexpr size_t WS_VC = WS_KC + 1 * MiB;
constexpr size_t WS_KMEAN = WS_VC + 1 * MiB;
constexpr size_t WS_SELM = WS_KMEAN + 1 * MiB;
constexpr size_t WS_OA = WS_SELM + 1 * MiB;
constexpr size_t WS_OC = WS_OA + 16 * MiB;
constexpr size_t WS_OG = WS_OC + 16 * MiB;
constexpr size_t WS_LSE = WS_OG + 24 * MiB;
constexpr size_t WS_OB = WS_LSE + 1 * MiB;
constexpr size_t WS_TMP = WS_OB + 8 * MiB;
constexpr size_t WS_MG = WS_TMP + 64 * MiB;
constexpr size_t WS_X1 = WS_MG + 32 * MiB;
constexpr size_t WS_X2 = WS_X1 + 64 * MiB;
constexpr size_t WS_U = WS_P;
constexpr size_t WS_SSP = WS_X2 + 64 * MiB;
constexpr size_t WS_END = WS_SSP + 5 * MiB;

constexpr int LDS_BYTES = 147456;

__device__ __forceinline__ unsigned f2bf(float f) { unsigned u = __builtin_bit_cast(unsigned, f); return (u + 0x7fffu + ((u >> 16) & 1u)) >> 16; }
__device__ __forceinline__ unsigned pk2(float lo, float hi) { return f2bf(lo) | (f2bf(hi) << 16); }
__device__ __forceinline__ float bf2f(bf16 b) { return __uint_as_float(((unsigned)b) << 16); }
__device__ __forceinline__ float sigm(float x) { return 1.0f / (1.0f + __expf(-x)); }
__device__ __forceinline__ float wave_sum(float v) {
#pragma unroll
    for (int o = 1; o < 64; o <<= 1) v += __shfl_xor(v, o);
    return v;
}
__device__ __forceinline__ int ltid() { int t = threadIdx.x; asm volatile("" : "+v"(t)); return t; }
__device__ __forceinline__ int lbid() { int t = blockIdx.x; asm volatile("" : "+s"(t)); return t; }
#define LDS_WAIT() asm volatile("s_waitcnt lgkmcnt(0)" ::: "memory")

struct Ctx {
    const float* in[17]; float* out; unsigned char* ws;
};

template <bool FRAG = false>
__device__ __forceinline__ void tr_item(const float* W, int K, int Nsrc, int src_n0, int nvalid, bf16* WT, int dst_row0, int k0, LAS float* scr, int lane, const float* gvec = nullptr, int dK = 0) {
    if (dK == 0) dK = K;
    {
        const int kr = lane >> 4, c4 = lane & 15;
        f32x4 v[16];
        const float* wp = W + (size_t)(k0 + kr) * Nsrc + src_n0 + 4 * c4;
#pragma unroll
        for (int i = 0; i < 16; ++i) v[i] = (4 * c4 < nvalid) ? *(const f32x4*)(wp + (size_t)(4 * i) * Nsrc) : (f32x4){0.f, 0.f, 0.f, 0.f};
#pragma unroll
        for (int i = 0; i < 16; ++i) { const float gk = gvec ? gvec[k0 + 4 * i + kr] : 1.0f; LAS float* sp = scr + (4 * i + kr) * 65 + 4 * c4; sp[0] = v[i][0] * gk; sp[1] = v[i][1] * gk; sp[2] = v[i][2] * gk; sp[3] = v[i][3] * gk; }
    }
    LDS_WAIT(); asm volatile("" ::: "memory");
    const int c = lane & 7;
#pragma unroll
    for (int j = 0; j < 8; ++j) {
        const int n = (lane >> 3) + 8 * j; const LAS float* s = scr + (8 * c) * 65 + n;
        v4u o; o.x = pk2(s[0 * 65], s[1 * 65]); o.y = pk2(s[2 * 65], s[3 * 65]); o.z = pk2(s[4 * 65], s[5 * 65]); o.w = pk2(s[6 * 65], s[7 * 65]);
        if (FRAG) {
            const int f = dst_row0 + n, k8 = (k0 >> 3) + c;
            *(v4u*)(WT + ((size_t)(((k8 >> 2) * 16 + (f >> 4)) * 64 + (k8 & 3) * 16 + (f & 15)) << 3)) = o;
        } else if (n < nvalid) *(v4u*)(WT + (size_t)(dst_row0 + n) * dK + k0 + 8 * c) = o;
    }
    LDS_WAIT(); asm volatile("" ::: "memory");
}
template <bool FRAG = false>
__device__ __forceinline__ bool tr_mat(int& r, const float* W, int K, int N, bf16* WT, LAS float* scr, int lane, const float* gvec = nullptr, int dK = 0) {
    const int nblk = N / 64, items = (K / 64) * nblk;
    if (r < items) { const int kb = r / nblk, nb = r % nblk; tr_item<FRAG>(W, K, N, nb * 64, 64, WT, nb * 64, kb * 64, scr, lane, gvec, dK); return true; }
    r -= items; return false;
}
__device__ __forceinline__ void phase_prep(const Ctx& C, LAS unsigned char* lds, bool do_bias) {
    const int tid = ltid(), lane = tid & 63, wave = tid >> 6;
    const int gw = lbid() * 8 + wave, NGW = gridDim.x * 8;
    unsigned char* ws = C.ws;
    LAS float* scr = (LAS float*)(lds + wave * 16640);
    constexpr int I_IN = 32 * 257;
    constexpr int PER_LAYER = I_IN + 16 * 32 + 8 * 32 + 16 * 32 + 32 * 32 + 32 * 128 + 128 * 32 + 64 * 4 + 4 * 2 + 64 * 4 + 4 * 2;
    for (int it = gw; it < 2 * PER_LAYER; it += NGW) {
        const int l = it / PER_LAYER; int r = it % PER_LAYER;
        if (r < I_IN) {
            const int kb = r / 257, nb = r % 257; const int n0 = nb * 64;
            const int src0 = (n0 < 2560) ? n0 : (n0 < 16384 ? n0 + 24 : 2560);
            tr_item(C.in[2] + (size_t)l * DM * IN_W, DM, IN_W, src0, nb == 256 ? 24 : 64, (bf16*)(ws + WS_WIN) + (size_t)l * PITCH * DM, n0, kb * 64, scr, lane, C.in[1] + (size_t)l * DM);
            continue;
        }
        r -= I_IN;
        if (tr_mat(r, C.in[9] + (size_t)l * 1024 * DM, 1024, DM, (bf16*)(ws + WS_WBA) + (size_t)l * DM * 2560, scr, lane, nullptr, 2560)) continue;
        if (tr_mat(r, C.in[10] + (size_t)l * 512 * DM, 512, DM, (bf16*)(ws + WS_WBA) + (size_t)l * DM * 2560 + 1024, scr, lane, nullptr, 2560)) continue;
        if (tr_mat(r, C.in[11] + (size_t)l * 1024 * DM, 1024, DM, (bf16*)(ws + WS_WBA) + (size_t)l * DM * 2560 + 1536, scr, lane, nullptr, 2560)) continue;
        if (tr_mat(r, C.in[12] + (size_t)l * DM * DM, DM, DM, (bf16*)(ws + WS_WO) + (size_t)l * DM * DM, scr, lane)) continue;
        if (tr_mat(r, C.in[14] + (size_t)l * DM * DFF, DM, DFF, (bf16*)(ws + WS_WMI) + (size_t)l * DFF * DM, scr, lane, C.in[13] + (size_t)l * DM)) continue;
        if (tr_mat(r, C.in[15] + (size_t)l * DFF * DM, DFF, DM, (bf16*)(ws + WS_WMO) + (size_t)l * DM * DFF, scr, lane)) continue;
        if (tr_mat<true>(r, C.in[4] + (size_t)l * 4096 * 256, 4096, 256, (bf16*)(ws + WS_W1T) + (size_t)(l * 2 + 0) * 256 * 4096, scr, lane)) continue;
        if (tr_mat(r, C.in[5] + (size_t)l * 256 * 128, 256, 128, (bf16*)(ws + WS_W2T) + (size_t)(l * 2 + 0) * 128 * 256, scr, lane)) continue;
        if (tr_mat<true>(r, C.in[7] + (size_t)l * 4096 * 256, 4096, 256, (bf16*)(ws + WS_W1T) + (size_t)(l * 2 + 1) * 256 * 4096, scr, lane)) continue;
        tr_mat(r, C.in[8] + (size_t)l * 256 * 128, 256, 128, (bf16*)(ws + WS_W2T) + (size_t)(l * 2 + 1) * 128 * 256, scr, lane);
    }
    float* rope = (float*)(ws + WS_ROPE);
    for (int e = lbid() * 512 + tid; e < 2048 * 16; e += gridDim.x * 512) {
        const int t = e >> 4, i = e & 15;
        const float inv = powf(500000.0f, -(float)(2 * i) / 32.0f);
        const float ang = (float)t * inv;
        rope[e] = cosf(ang); rope[2048 * 16 + e] = sinf(ang);
    }
    float* bias = (float*)(ws + WS_BIASP);
    if (do_bias) for (int task = gw; task < 4 * 4 * 32; task += NGW) {
        const int kc = task & 31, fc = (task >> 5) & 3, lk = task >> 7, l = lk >> 1, kv = lk & 1;
        const float* pe = C.in[kv ? 6 : 3] + (size_t)l * 4096;
        const float* w1 = C.in[kv ? 7 : 4] + (size_t)l * 4096 * 256;
        float acc = 0.f;
#pragma unroll 8
        for (int k = kc * 128; k < kc * 128 + 128; ++k) acc += pe[k] * w1[(size_t)k * 256 + fc * 64 + lane];
        bias[(lk * 32 + kc) * 256 + fc * 64 + lane] = acc;
    }
}

__device__ __forceinline__ void phase_cast(const float* x, bf16* ob, float* ssp) {
    const int tid = ltid(), lane = tid & 63, wave = tid >> 6;
    const int gw = lbid() * 8 + wave, NGW = gridDim.x * 8;
    for (int row = gw; row < TOK; row += NGW) {
        const float* xr = x + (size_t)row * DM;
        f32x4 v[8]; float ss = 0.f;
#pragma unroll
        for (int j = 0; j < 8; ++j) { v[j] = *(const f32x4*)(xr + (64 * j + lane) * 4); ss += (v[j][0] * v[j][0] + v[j][1] * v[j][1]) + (v[j][2] * v[j][2] + v[j][3] * v[j][3]); }
        ss = wave_sum(ss);
#pragma unroll
        for (int j = 0; j < 8; ++j) { v2u w; w.x = pk2(v[j][0], v[j][1]); w.y = pk2(v[j][2], v[j][3]); *(v2u*)(ob + (size_t)row * DM + (64 * j + lane) * 4) = w; }
        if (lane < 32) ssp[(size_t)row * 32 + lane] = (lane == 0) ? ss : 0.f;
    }
}
__device__ __forceinline__ void phase_final(const float* x, const float* g, const float* ssp, float* of) {
    const int tid = ltid(), lane = tid & 63, wave = tid >> 6;
    const int gw = lbid() * 8 + wave, NGW = gridDim.x * 8;
    f32x4 gv[8];
#pragma unroll
    for (int j = 0; j < 8; ++j) gv[j] = *(const f32x4*)(g + (64 * j + lane) * 4);
    for (int row = gw; row < TOK; row += NGW) {
        const float rs = pg8::row_rscale(ssp, row);
        const float* xr = x + (size_t)row * DM;
#pragma unroll
        for (int j = 0; j < 8; ++j) { const f32x4 y = *(const f32x4*)(xr + (64 * j + lane) * 4) * rs * gv[j]; *(f32x4*)(of + (size_t)row * DM + (64 * j + lane) * 4) = y; }
    }
}
template <bool OUTF32>
__device__ __forceinline__ void phase_norm(const float* x, const float* g, bf16* ob, float* of) {
    const int tid = ltid(), lane = tid & 63, wave = tid >> 6;
    const int gw = lbid() * 8 + wave, NGW = gridDim.x * 8;
    f32x4 gv[8];
#pragma unroll
    for (int j = 0; j < 8; ++j) gv[j] = *(const f32x4*)(g + (64 * j + lane) * 4);
    for (int row = gw; row < TOK; row += NGW) {
        const float* xr = x + (size_t)row * DM;
        f32x4 v[8]; float ss = 0.f;
#pragma unroll
        for (int j = 0; j < 8; ++j) { v[j] = *(const f32x4*)(xr + (64 * j + lane) * 4); ss += (v[j][0] * v[j][0] + v[j][1] * v[j][1]) + (v[j][2] * v[j][2] + v[j][3] * v[j][3]); }
        const float rs = rsqrtf(wave_sum(ss) * (1.0f / DM) + 1e-6f);
#pragma unroll
        for (int j = 0; j < 8; ++j) {
            const f32x4 y = v[j] * rs * gv[j];
            if (OUTF32) *(f32x4*)(of + (size_t)row * DM + (64 * j + lane) * 4) = y;
            else { v2u w; w.x = pk2(y[0], y[1]); w.y = pk2(y[2], y[3]); *(v2u*)(ob + (size_t)row * DM + (64 * j + lane) * 4) = w; }
        }
    }
}

namespace att {
constexpr int KP = 288, VP = 288, KTB = 64 * KP, VTB = 64 * VP, BUFB = KTB + VTB;
constexpr int MISC = 2 * BUFB;
constexpr float SC = 0.08838834764831845f * 1.4426950408889634f;
constexpr float NEG_INF = -__builtin_inff();

struct Cfg { const bf16* K; const bf16* V; size_t kstride; int jt_lo, jt_hi, W, bshift; unsigned tor; };
typedef unsigned u32x2_t __attribute__((ext_vector_type(2)));
__device__ __forceinline__ float rows_max(float v) {
    u32x2_t r = __builtin_amdgcn_permlane32_swap(__float_as_uint(v), __float_as_uint(v), false, false);
    const float a = fmaxf(__uint_as_float(r.x), __uint_as_float(r.y));
    r = __builtin_amdgcn_permlane16_swap(__float_as_uint(a), __float_as_uint(a), false, false);
    return fmaxf(__uint_as_float(r.x), __uint_as_float(r.y));
}
__device__ __forceinline__ float rows_sum(float v) {
    u32x2_t r = __builtin_amdgcn_permlane32_swap(__float_as_uint(v), __float_as_uint(v), false, false);
    const float a = __uint_as_float(r.x) + __uint_as_float(r.y);
    r = __builtin_amdgcn_permlane16_swap(__float_as_uint(a), __float_as_uint(a), false, false);
    return __uint_as_float(r.x) + __uint_as_float(r.y);
}

__device__ __forceinline__ bool tile_on(const Cfg& c, int jt) { return c.bshift < 0 || ((c.tor >> ((jt * 64) >> c.bshift)) & 1u); }
__device__ __forceinline__ int next_tile(const Cfg& c, int jt) { while (jt <= c.jt_hi && !tile_on(c, jt)) ++jt; return jt; }

__device__ __forceinline__ void tile_gload(const Cfg& c, int jt, int tid, v4u (&kr)[2], v4u (&vr)[2]) {
#pragma unroll
    for (int i = 0; i < 2; ++i) {
        const int ch = tid + i * 512, row = ch >> 4, c16 = ch & 15;
        const size_t off = (size_t)(jt * 64 + row) * c.kstride + c16 * 8;
        kr[i] = *(const v4u*)(c.K + off); vr[i] = *(const v4u*)(c.V + off);
    }
}
__device__ __forceinline__ void tile_lwrite(LAS unsigned char* buf, int tid, const v4u (&kr)[2], const v4u (&vr)[2]) {
#pragma unroll
    for (int i = 0; i < 2; ++i) {
        const int ch = tid + i * 512, row = ch >> 4, c16 = ch & 15;
        *(LAS v4u*)(buf + row * KP + c16 * 16) = kr[i];
        *(LAS v4u*)(buf + KTB + row * VP + c16 * 16) = vr[i];
    }
}
__device__ __forceinline__ s16x4 vtr(const LAS unsigned char* p) { return __builtin_bit_cast(s16x4, __builtin_amdgcn_ds_read_tr16_b64_v4i16((LAS s16x4*)p)); }
__device__ __forceinline__ bf16x8 pack8(const f32x4& a, const f32x4& b) {
    v4u w; w.x = pg8::cvt_pk_bf16(a[0], a[1]); w.y = pg8::cvt_pk_bf16(a[2], a[3]); w.z = pg8::cvt_pk_bf16(b[0], b[1]); w.w = pg8::cvt_pk_bf16(b[2], b[3]);
    return __builtin_bit_cast(bf16x8, w);
}
template <int NT>
__device__ __forceinline__ void pv_chunk(const LAS unsigned char* vt, int cc, int li, int q4, const bf16x8 (&pf)[NT], f32x4 (&o)[NT][8]) {
    const LAS unsigned char* vp = vt + (cc * 32 + 4 * q4 + (li >> 2)) * VP + (4 * (li & 3)) * 2;
#pragma unroll
    for (int dg = 0; dg < 2; ++dg) {
        s16x4 v0[4], v1[4];
        asm volatile("s_waitcnt lgkmcnt(0)" ::: "memory");
#pragma unroll
        for (int d = 0; d < 4; ++d) { v0[d] = vtr(vp + (dg * 4 + d) * 32); v1[d] = vtr(vp + (dg * 4 + d) * 32 + 16 * VP); }
        __builtin_amdgcn_sched_barrier(0);
#pragma unroll
        for (int d = 0; d < 4; ++d) {
            bf16x8 vf; vf[0] = v0[d][0]; vf[1] = v0[d][1]; vf[2] = v0[d][2]; vf[3] = v0[d][3]; vf[4] = v1[d][0]; vf[5] = v1[d][1]; vf[6] = v1[d][2]; vf[7] = v1[d][3];
#pragma unroll
            for (int nt = 0; nt < NT; ++nt) o[nt][dg * 4 + d] = __builtin_amdgcn_mfma_f32_16x16x32_bf16(vf, pf[nt], o[nt][dg * 4 + d], 0, 0, 0);
        }
        __builtin_amdgcn_sched_barrier(0);
    }
}

template <int NT>
__device__ __forceinline__ void tile_compute(const LAS unsigned char* buf, const Cfg& c, int jt, int lane, const bf16x8 (&qf)[NT][4], const int (&qpos)[NT], const unsigned (&bits)[NT],
                                             f32x4 (&o)[NT][8], float (&m)[NT], float (&l)[NT], int qmin) {
    const int li = lane & 15, q4 = lane >> 4;
    const int k0 = jt * 64, qmax = qmin + 16 * NT - 1;
    bool anyrow = true, allrow = true;
    if (c.bshift >= 0) {
        bool hit = false, all = true;
#pragma unroll
        for (int nt = 0; nt < NT; ++nt) { const bool b = (bits[nt] >> (k0 >> c.bshift)) & 1u; hit = hit || b; all = all && b; }
        anyrow = __builtin_amdgcn_ballot_w64(hit) != 0ull; allrow = __builtin_amdgcn_ballot_w64(!all) == 0ull;
    }
    if (!(k0 <= qmax && qmin - (k0 + 63) < c.W && anyrow)) return;
    const bool full = allrow && (k0 + 63 <= qmin) && (qmax - k0 < c.W);
    f32x4 s[NT][4];
#pragma unroll
    for (int nt = 0; nt < NT; ++nt)
#pragma unroll
        for (int kb = 0; kb < 4; ++kb) s[nt][kb] = (f32x4){0.f, 0.f, 0.f, 0.f};
    const LAS unsigned char* kp = buf + li * KP + q4 * 16;
#pragma unroll
    for (int ks = 0; ks < 4; ++ks)
#pragma unroll
        for (int kb = 0; kb < 4; ++kb) {
            const bf16x8 kf = *(const LAS bf16x8*)(kp + kb * 16 * KP + ks * 64);
#pragma unroll
            for (int nt = 0; nt < NT; ++nt) s[nt][kb] = __builtin_amdgcn_mfma_f32_16x16x32_bf16(kf, qf[nt][ks], s[nt][kb], 0, 0, 0);
        }
    bf16x8 pf[2][NT];
#pragma unroll
    for (int nt = 0; nt < NT; ++nt) {
        float mx = NEG_INF;
        if (full) {
#pragma unroll
            for (int kb = 0; kb < 4; ++kb) mx = fmaxf(mx, fmaxf(fmaxf(s[nt][kb][0], s[nt][kb][1]), fmaxf(s[nt][kb][2], s[nt][kb][3])));
        } else {
            const int hi = qpos[nt] - (jt * 64 + q4 * 4);
            unsigned wrow = (unsigned)c.W;
            if (c.bshift >= 0) wrow = ((bits[nt] >> ((jt * 64) >> c.bshift)) & 1u) ? wrow : 0u;
#pragma unroll
            for (int kb = 0; kb < 4; ++kb)
#pragma unroll
                for (int jj = 0; jj < 4; ++jj) {
                    const bool ok = (unsigned)(hi - (kb * 16 + jj)) < wrow;
                    const float x = ok ? s[nt][kb][jj] : NEG_INF;
                    s[nt][kb][jj] = x; mx = fmaxf(mx, x);
                }
        }
        mx = rows_max(mx);
        const float mn = fmaxf(m[nt], mx), alpha = __builtin_amdgcn_exp2f((m[nt] - mn) * SC);
        m[nt] = mn;
        const float nms = -mn * SC;
        float rs = 0.f;
#pragma unroll
        for (int kb = 0; kb < 4; ++kb)
#pragma unroll
            for (int jj = 0; jj < 4; ++jj) { const float p = __builtin_amdgcn_exp2f(__builtin_fmaf(s[nt][kb][jj], SC, nms)); s[nt][kb][jj] = p; rs += p; }
        rs = rows_sum(rs);
        l[nt] = l[nt] * alpha + rs;
        if (__builtin_amdgcn_ballot_w64(alpha != 1.0f) != 0ull) {
#pragma unroll
            for (int db = 0; db < 8; ++db) o[nt][db] = o[nt][db] * alpha;
        }
        pf[0][nt] = pack8(s[nt][0], s[nt][1]); pf[1][nt] = pack8(s[nt][2], s[nt][3]);
    }
    const LAS unsigned char* vt = buf + KTB;
    pv_chunk<NT>(vt, 0, li, q4, pf[0], o);
    pv_chunk<NT>(vt, 1, li, q4, pf[1], o);
}

template <int NT>
__device__ __forceinline__ void run_attn(LAS unsigned char* lds, const Cfg& c, const bf16* qbase, const unsigned (&qoff)[NT], const int (&qpos)[NT], const unsigned (&bits)[NT],
                                         bf16* dbase, const unsigned (&doff)[NT], const float (&gate)[NT], bool accum, float* lsebase) {
    const int tid = ltid(), lane = tid & 63, li = lane & 15, q4 = lane >> 4;
    bf16x8 qf[NT][4];
#pragma unroll
    for (int nt = 0; nt < NT; ++nt)
#pragma unroll
        for (int ks = 0; ks < 4; ++ks) qf[nt][ks] = *(const bf16x8*)(qbase + (size_t)qoff[nt] + ks * 32 + q4 * 8);
    f32x4 o[NT][8]; float m[NT], l[NT];
#pragma unroll
    for (int nt = 0; nt < NT; ++nt) {
        m[nt] = -1e30f; l[nt] = 0.f;
#pragma unroll
        for (int db = 0; db < 8; ++db) o[nt][db] = (f32x4){0.f, 0.f, 0.f, 0.f};
    }
    const int qmin = __builtin_amdgcn_readfirstlane(qpos[0]);
    __syncthreads();
#define ATT_BAR() do { asm volatile("s_waitcnt lgkmcnt(0)" ::: "memory"); __builtin_amdgcn_s_barrier(); asm volatile("" ::: "memory"); } while (0)
    int jt = next_tile(c, c.jt_lo);
    if (jt <= c.jt_hi) {
        v4u ka[2], va[2], kb[2], vb[2];
        tile_gload(c, jt, tid, ka, va);
        tile_lwrite(lds, tid, ka, va);
        int jn = next_tile(c, jt + 1);
        if (jn <= c.jt_hi) tile_gload(c, jn, tid, ka, va);
        ATT_BAR();
        int bsel = 0;
        for (;;) {
            int jn2 = (jn <= c.jt_hi) ? next_tile(c, jn + 1) : jn;
            if (jn2 <= c.jt_hi) tile_gload(c, jn2, tid, kb, vb);
            tile_compute<NT>(lds + bsel * BUFB, c, jt, lane, qf, qpos, bits, o, m, l, qmin);
            if (jn <= c.jt_hi) tile_lwrite(lds + (bsel ^ 1) * BUFB, tid, ka, va);
            ATT_BAR();
            if (jn > c.jt_hi) break;
            jt = jn; jn = jn2; bsel ^= 1;
            jn2 = (jn <= c.jt_hi) ? next_tile(c, jn + 1) : jn;
            if (jn2 <= c.jt_hi) tile_gload(c, jn2, tid, ka, va);
            tile_compute<NT>(lds + bsel * BUFB, c, jt, lane, qf, qpos, bits, o, m, l, qmin);
            if (jn <= c.jt_hi) tile_lwrite(lds + (bsel ^ 1) * BUFB, tid, kb, vb);
            ATT_BAR();
            if (jn > c.jt_hi) break;
            jt = jn; jn = jn2; bsel ^= 1;
        }
    }
#undef ATT_BAR
#pragma unroll
    for (int nt = 0; nt < NT; ++nt) {
        const float sc = gate[nt] / fmaxf(l[nt], 1e-30f);
        bf16* dp = dbase + (size_t)doff[nt] + q4 * 4;
#pragma unroll
        for (int db = 0; db < 8; ++db) {
            f32x4 v = o[nt][db] * sc;
            if (accum) { const unsigned long long ow = __hip_atomic_load((const unsigned long long*)(dp + db * 16), __ATOMIC_RELAXED, __HIP_MEMORY_SCOPE_AGENT); v2u old; old.x = (unsigned)ow; old.y = (unsigned)(ow >> 32); v[0] += pg8::bf_lo(old.x); v[1] += pg8::bf_hi(old.x); v[2] += pg8::bf_lo(old.y); v[3] += pg8::bf_hi(old.y); }
            v2u w; w.x = pg8::cvt_pk_bf16(v[0], v[1]); w.y = pg8::cvt_pk_bf16(v[2], v[3]);
            *(v2u*)(dp + db * 16) = w;
        }
        if (lsebase != nullptr && q4 == 0) lsebase[doff[nt] >> 7] = (m[nt] * SC + log2f(fmaxf(l[nt], 1e-30f))) * 0.6931471805599453f;
    }
}
}

struct Bufs {
    bf16 *P, *GM, *QR, *KC, *VC, *OA, *OC, *OG, *OB; float *KMEAN, *LSE; unsigned* SELM;
};

template <int NT>
__device__ __forceinline__ void unit_dilated(LAS unsigned char* lds, const Bufs& B, int gi, int r, int b, int hh, int cls, int i0) {
    const int tid = ltid(), lane = tid & 63, wave = tid >> 6, li = lane & 15;
    constexpr int ROWS = NT * 128;
    const int head = gi * 4 + hh;
    att::Cfg c;
    c.K = B.P + hmo(b, 32 + head) + cls * 128; c.V = B.P + hmo(b, 44 + head) + cls * 128; c.kstride = (size_t)r * 128;
    c.jt_lo = (i0 >= 128) ? ((i0 - 128) >> 6) : 0; c.jt_hi = (i0 + ROWS - 1) >> 6; c.W = 129; c.bshift = -1; c.tor = 0u;
    unsigned qoff[NT]; int qpos[NT]; unsigned bits[NT]; unsigned doff[NT]; float gate[NT];
#pragma unroll
    for (int nt = 0; nt < NT; ++nt) {
        const int i = i0 + NT * 16 * wave + 16 * nt + li, tok = cls + r * i;
        qoff[nt] = (unsigned)tok * 128u; qpos[nt] = i; bits[nt] = 0u;
        doff[nt] = (unsigned)(gi * TOK + b * SEQ + tok) * 512u + hh * 128; gate[nt] = 1.0f;
    }
    att::run_attn<NT>(lds, c, B.P + hmo(b, 20 + head), qoff, qpos, bits, B.OG, doff, gate, false, B.LSE);
}

__device__ __forceinline__ void unit_cmp(LAS unsigned char* lds, const Bufs& B, int uidx) {
    using namespace att;
    const int tid = ltid(), lane = tid & 63, wave = tid >> 6, li = lane & 15, q4 = lane >> 4;
    const int q_blk = uidx & 31, g = (uidx >> 5) & 1, b = uidx >> 6;
    __syncthreads();
    {
        const bf16* Kc = B.KC + (size_t)((b * 2 + g) * 128) * 128; const bf16* Vc = B.VC + (size_t)((b * 2 + g) * 128) * 128;
#pragma unroll
        for (int i = 0; i < 4; ++i) {
            const int ch = tid + i * 512, row = ch >> 4, c16 = ch & 15, bf = row >> 6, rr = row & 63;
            const v4u kv = *(const v4u*)(Kc + row * 128 + c16 * 8), vv = *(const v4u*)(Vc + row * 128 + c16 * 8);
            *(LAS v4u*)(lds + bf * BUFB + rr * KP + c16 * 16) = kv;
            *(LAS v4u*)(lds + bf * BUFB + KTB + rr * VP + c16 * 16) = vv;
        }
    }
    int tt[2], hh[2]; bf16x8 qf[2][4];
#pragma unroll
    for (int nt = 0; nt < 2; ++nt) {
        const int R = 32 * wave + 16 * nt + li; tt[nt] = 64 * q_blk + (R >> 2); hh[nt] = g * 4 + (R & 3);
        const bf16* qp = B.P + hmo(b, hh[nt]) + tt[nt] * 128 + q4 * 8;
#pragma unroll
        for (int ks = 0; ks < 4; ++ks) qf[nt][ks] = *(const bf16x8*)(qp + ks * 32);
    }
    __syncthreads();
    f32x4 s[2][8];
#pragma unroll
    for (int nt = 0; nt < 2; ++nt)
#pragma unroll
        for (int kb = 0; kb < 8; ++kb) s[nt][kb] = (f32x4){0.f, 0.f, 0.f, 0.f};
#pragma unroll
    for (int bf = 0; bf < 2; ++bf) {
        const LAS unsigned char* kp = lds + bf * BUFB + li * KP + q4 * 16;
#pragma unroll
        for (int ks = 0; ks < 4; ++ks)
#pragma unroll
            for (int kb = 0; kb < 4; ++kb) {
                const bf16x8 kf = *(const LAS bf16x8*)(kp + kb * 16 * KP + ks * 64);
#pragma unroll
                for (int nt = 0; nt < 2; ++nt) s[nt][bf * 4 + kb] = __builtin_amdgcn_mfma_f32_16x16x32_bf16(kf, qf[nt][ks], s[nt][bf * 4 + kb], 0, 0, 0);
            }
    }
    LAS float* impbuf = (LAS float*)(lds + MISC);
    bf16x8 pf[4][2];
#pragma unroll
    for (int nt = 0; nt < 2; ++nt) {
        const int qpos = (tt[nt] >= 31) ? ((tt[nt] - 31) >> 4) : -1;
        float mx = NEG_INF;
#pragma unroll
        for (int kb = 0; kb < 8; ++kb)
#pragma unroll
            for (int jj = 0; jj < 4; ++jj) { const int j = kb * 16 + q4 * 4 + jj; const float x = (j <= qpos) ? s[nt][kb][jj] * SC : NEG_INF; s[nt][kb][jj] = x; mx = fmaxf(mx, x); }
        mx = fmaxf(mx, __shfl_xor(mx, 16)); mx = fmaxf(mx, __shfl_xor(mx, 32)); mx = fmaxf(mx, -1e30f);
        float rs = 0.f;
#pragma unroll
        for (int kb = 0; kb < 8; ++kb)
#pragma unroll
            for (int jj = 0; jj < 4; ++jj) { const float p = __builtin_amdgcn_exp2f(s[nt][kb][jj] - mx); s[nt][kb][jj] = p; rs += p; }
        rs += __shfl_xor(rs, 16); rs += __shfl_xor(rs, 32);
        const float inv = 1.0f / fmaxf(rs, 1e-30f);
        float xprev = 0.f;
#pragma unroll
        for (int kb = 0; kb < 8; ++kb) {
            s[nt][kb] = s[nt][kb] * inv;
            const float own = (s[nt][kb][0] + s[nt][kb][1]) + (s[nt][kb][2] + 0.5f * s[nt][kb][3]);
            const float x3 = 0.5f * s[nt][kb][3];
            const float snd = (q4 == 3) ? xprev : x3;
            const float rcv = __shfl(snd, (lane + 48) & 63);
            xprev = x3;
            float tot = own + rcv;
            tot += __shfl_xor(tot, 1); tot += __shfl_xor(tot, 2);
            if ((li & 3) == 0) impbuf[(8 * wave + 4 * nt + (li >> 2)) * 32 + kb * 4 + q4] = tot;
        }
#pragma unroll
        for (int c = 0; c < 4; ++c) pf[c][nt] = pack8(s[nt][2 * c], s[nt][2 * c + 1]);
    }
    f32x4 o[2][8];
#pragma unroll
    for (int nt = 0; nt < 2; ++nt)
#pragma unroll
        for (int db = 0; db < 8; ++db) o[nt][db] = (f32x4){0.f, 0.f, 0.f, 0.f};
#pragma unroll
    for (int c = 0; c < 4; ++c) pv_chunk<2>(lds + (c >> 1) * BUFB + KTB, c & 1, li, q4, pf[c], o);
#pragma unroll
    for (int nt = 0; nt < 2; ++nt) {
        const size_t rowg = (size_t)(b * SEQ + tt[nt]);
        const float gate = sigm(bf2f(B.GM[rowg * GMP + 6144 + hh[nt] * 3 + 0]));
        bf16* dp = B.OA + rowg * 2560 + hh[nt] * 128 + q4 * 4;
#pragma unroll
        for (int db = 0; db < 8; ++db) { const f32x4 v = o[nt][db] * gate; v2u w; w.x = pg8::cvt_pk_bf16(v[0], v[1]); w.y = pg8::cvt_pk_bf16(v[2], v[3]); *(v2u*)(dp + db * 16) = w; }
    }
    __syncthreads();
#pragma unroll 1
    for (int i = 0; i < 4; ++i) {
        const int idx = tid + i * 512, tl = idx >> 5, j = idx & 31;
        bool sel;
        if (j > q_blk) sel = false;
        else if (q_blk < 16) sel = true;
        else if (j == 0 || j >= q_blk - 1) sel = true;
        else {
            const float me = impbuf[tl * 32 + j]; int rank = 0;
            for (int jp = 1; jp <= q_blk - 2; ++jp) { const float ov = impbuf[tl * 32 + jp]; rank += ((ov > me) || (ov == me && jp < j)) ? 1 : 0; }
            sel = rank < 13;
        }
        const unsigned long long bal = __ballot(sel);
        if ((lane & 31) == 0) B.SELM[(size_t)(b * SEQ + 64 * q_blk + tl) * 2 + g] = (lane < 32) ? (unsigned)bal : (unsigned)(bal >> 32);
    }
}

__device__ __forceinline__ void unit_nsa(LAS unsigned char* lds, const Bufs& B, int uidx) {
    const int tid = ltid(), lane = tid & 63, wave = tid >> 6, li = lane & 15;
    const int q_blk = uidx & 31, g = (uidx >> 5) & 1, b = uidx >> 6;
    unsigned qoff[2], doff[2]; int qpos[2]; unsigned bits[2]; float gate[2]; int gcol[2];
    unsigned ob = 0u;
#pragma unroll
    for (int nt = 0; nt < 2; ++nt) {
        const int R = 32 * wave + 16 * nt + li, rr = R >> 6, t = 64 * q_blk + (R & 63), h = g * 4 + rr;
        qoff[nt] = (unsigned)((b * 8 + h) * SEQ + t) * 128u; doff[nt] = (unsigned)(b * SEQ + t) * 2560u + h * 128; qpos[nt] = t;
        bits[nt] = __hip_atomic_load(B.SELM + (size_t)(b * SEQ + t) * 2 + g, __ATOMIC_RELAXED, __HIP_MEMORY_SCOPE_AGENT); ob |= bits[nt];
        gcol[nt] = 6144 + h * 3;
    }
#pragma unroll
    for (int o = 1; o < 64; o <<= 1) ob |= __shfl_xor(ob, o);
    LAS unsigned* orw = (LAS unsigned*)(lds + att::MISC);
    __syncthreads();
    if (tid == 0) orw[0] = 0u;
    __syncthreads();
    if (lane == 0) __hip_atomic_fetch_or(orw, ob, __ATOMIC_RELAXED, __HIP_MEMORY_SCOPE_WORKGROUP);
    __syncthreads();
    const unsigned tor = orw[0];
#pragma unroll 1
    for (int pass = 0; pass < 2; ++pass) {
        att::Cfg c;
        c.K = B.P + hmo(b, (pass == 0 ? 12 : 16) + g); c.V = B.P + hmo(b, (pass == 0 ? 14 : 18) + g); c.kstride = 128;
        c.jt_lo = (pass == 0) ? 0 : (q_blk >= 8 ? q_blk - 8 : 0); c.jt_hi = q_blk;
        c.W = (pass == 0) ? (1 << 30) : 512; c.bshift = (pass == 0) ? 6 : -1; c.tor = tor;
#pragma unroll
        for (int nt = 0; nt < 2; ++nt) gate[nt] = sigm(bf2f(B.GM[(size_t)(b * SEQ + qpos[nt]) * GMP + gcol[nt] + 1 + pass]));
        att::run_attn<2>(lds, c, B.QR, qoff, qpos, bits, B.OA, doff, gate, true, nullptr);
    }
}

__device__ __forceinline__ void unit_moba(LAS unsigned char* lds, const Bufs& B, int b, int h, int qb) {
    const int tid = ltid(), lane = tid & 63, wave = tid >> 6, li = lane & 15;
    LAS unsigned* mb = (LAS unsigned*)(lds + att::MISC);
    __syncthreads();
    if (tid == 0) mb[256] = 0u;
    {
        const int row = tid >> 1, half = tid & 1, t = 256 * qb + row;
        const bf16* qp = B.P + hmo(b, 56 + h) + t * 128 + half * 64;
        const float* km = B.KMEAN + (size_t)((b * 8 + h) * 8) * 128 + half * 64;
        float acc[7];
#pragma unroll
        for (int j = 0; j < 7; ++j) acc[j] = 0.f;
#pragma unroll 2
        for (int ch = 0; ch < 8; ++ch) {
            const v4u qw = *(const v4u*)(qp + ch * 8);
            float q[8]; q[0] = pg8::bf_lo(qw.x); q[1] = pg8::bf_hi(qw.x); q[2] = pg8::bf_lo(qw.y); q[3] = pg8::bf_hi(qw.y); q[4] = pg8::bf_lo(qw.z); q[5] = pg8::bf_hi(qw.z); q[6] = pg8::bf_lo(qw.w); q[7] = pg8::bf_hi(qw.w);
#pragma unroll
            for (int j = 0; j < 7; ++j) if (j < qb) {
                const f32x4 k0 = *(const f32x4*)(km + j * 128 + ch * 8), k1 = *(const f32x4*)(km + j * 128 + ch * 8 + 4);
                acc[j] += (q[0] * k0[0] + q[1] * k0[1]) + (q[2] * k0[2] + q[3] * k0[3]) + (q[4] * k1[0] + q[5] * k1[1]) + (q[6] * k1[2] + q[7] * k1[3]);
            }
        }
        unsigned bt = 0u;
#pragma unroll
        for (int j = 0; j < 7; ++j) acc[j] += __shfl_xor(acc[j], 1);
        if (qb <= 3) bt = (1u << qb) - 1u;
        else {
#pragma unroll
            for (int j = 0; j < 7; ++j) if (j < qb) {
                int rank = 0;
#pragma unroll
                for (int jp = 0; jp < 7; ++jp) if (jp < qb && jp != j) rank += ((acc[jp] > acc[j]) || (acc[jp] == acc[j] && jp < j)) ? 1 : 0;
                if (rank < 3) bt |= 1u << j;
            }
        }
        bt |= 1u << qb;
        if (half == 0) mb[row] = bt;
        unsigned ob = bt;
#pragma unroll
        for (int o = 1; o < 64; o <<= 1) ob |= __shfl_xor(ob, o);
        __syncthreads();
        if (lane == 0) __hip_atomic_fetch_or(mb + 256, ob, __ATOMIC_RELAXED, __HIP_MEMORY_SCOPE_WORKGROUP);
        __syncthreads();
    }
    att::Cfg c;
    c.K = B.P + hmo(b, 64 + h); c.V = B.P + hmo(b, 72 + h); c.kstride = 128; c.jt_lo = 0; c.jt_hi = 4 * qb + 3; c.W = 1 << 30; c.bshift = 8; c.tor = mb[256];
    unsigned qoff[2]; int qpos[2]; unsigned bits[2]; unsigned doff[2]; float gate[2];
#pragma unroll
    for (int nt = 0; nt < 2; ++nt) {
        const int R = 32 * wave + 16 * nt + li, t = 256 * qb + R;
        qoff[nt] = (unsigned)t * 128u; qpos[nt] = t; bits[nt] = mb[R];
        doff[nt] = (unsigned)(b * SEQ + t) * 2560u + h * 128; gate[nt] = 1.0f;
    }
    att::run_attn<2>(lds, c, B.P + hmo(b, 56 + h), qoff, qpos, bits, B.OC, doff, gate, false, nullptr);
}

__device__ __forceinline__ float gelu_tanh(float x) {
    const float u = 0.7978845608028654f * (x + 0.044715f * x * x * x);
    const float e = __expf(2.0f * u);
    const float th = 1.0f - 2.0f / (e + 1.0f);
    return 0.5f * x * (1.0f + th);
}
__device__ __forceinline__ void unit_compress(LAS unsigned char* lds, const Bufs& B, const bf16* W1T, const bf16* W2T, const float* bias, int kv, int rt) {
    const int tid = ltid(), lane = tid & 63, wave = tid >> 6, li = lane & 15, q4 = lane >> 4;
    LAS float* hacc = (LAS float*)lds;
    LAS unsigned char* hb = lds + 131072;
    LAS float* bsum = (LAS float*)(lds + 131072 + 8448);
    __syncthreads();
    if (tid < 256) { float bs = 0.f;
#pragma unroll 8
        for (int kc = 0; kc < 32; ++kc) bs += bias[kc * 256 + tid];
        bsum[tid] = bs; }
    const int rho0 = rt * 32 + li, bg = rho0 >> 7, b = bg >> 1, g = bg & 1;
    const bf16* abase = B.P + hmo(b, (kv ? 10 : 8) + g);
    f32x4 acc[2][16];
#pragma unroll
    for (int tl = 0; tl < 2; ++tl)
#pragma unroll
        for (int nb = 0; nb < 16; ++nb) acc[tl][nb] = (f32x4){0.f, 0.f, 0.f, 0.f};
#pragma unroll 1
    for (int ll = 0; ll < 4; ++ll) {
        const int l = 4 * wave + ll;
        int tok0 = 16 * (rho0 & 127) + l, tok1 = tok0 + 256; tok0 = tok0 > SEQ - 1 ? SEQ - 1 : tok0; tok1 = tok1 > SEQ - 1 ? SEQ - 1 : tok1;
        const bf16* ap0 = abase + tok0 * 128 + q4 * 8;
        const bf16* ap1 = abase + tok1 * 128 + q4 * 8;
        const bf16* bp = W1T + ((size_t)(l * 4) * 16 * 64 + lane) * 8;
#pragma unroll
        for (int ds = 0; ds < 4; ++ds) {
            const bf16x8 af0 = *(const bf16x8*)(ap0 + ds * 32), af1 = *(const bf16x8*)(ap1 + ds * 32);
#pragma unroll
            for (int nb = 0; nb < 16; ++nb) {
                const bf16x8 bfr = *(const bf16x8*)(bp + (size_t)((ds * 16 + nb) * 64) * 8);
                acc[0][nb] = __builtin_amdgcn_mfma_f32_16x16x32_bf16(af0, bfr, acc[0][nb], 0, 0, 0);
                acc[1][nb] = __builtin_amdgcn_mfma_f32_16x16x32_bf16(af1, bfr, acc[1][nb], 0, 0, 0);
            }
        }
    }
    bf16* outp = (kv ? B.VC : B.KC);
#pragma unroll
    for (int tl = 0; tl < 2; ++tl) {
#pragma unroll
        for (int nb = 0; nb < 16; ++nb)
#pragma unroll
            for (int jj = 0; jj < 4; ++jj) hacc[wave * 4096 + (4 * q4 + jj) * 256 + nb * 16 + li] = acc[tl][nb][jj];
        __syncthreads();
        for (int e = tid; e < 4096; e += 512) {
            const int row = e >> 8, f = e & 255;
            float hs = 0.f;
#pragma unroll
            for (int w = 0; w < 8; ++w) hs += hacc[w * 4096 + e];
            const float v = gelu_tanh(hs + bsum[f]);
            *(LAS bf16*)(hb + row * 528 + f * 2) = (bf16)f2bf(v);
        }
        __syncthreads();
        f32x4 o2 = (f32x4){0.f, 0.f, 0.f, 0.f};
#pragma unroll
        for (int ks = 0; ks < 8; ++ks) {
            const bf16x8 af = *(const LAS bf16x8*)(hb + li * 528 + (ks * 32 + q4 * 8) * 2);
            const bf16x8 bfr = *(const bf16x8*)(W2T + (size_t)(wave * 16 + li) * 256 + ks * 32 + q4 * 8);
            o2 = __builtin_amdgcn_mfma_f32_16x16x32_bf16(af, bfr, o2, 0, 0, 0);
        }
#pragma unroll
        for (int jj = 0; jj < 4; ++jj) outp[(size_t)(rt * 32 + tl * 16 + 4 * q4 + jj) * 128 + wave * 16 + li] = (bf16)f2bf(o2[jj]);
        __syncthreads();
    }
}
__device__ __forceinline__ void gate_gemm(const Bufs& B, const bf16* H, const bf16* Wg, const float* ssp, int gwv, int nwv) {
    const int lane = ltid() & 63, li = lane & 15, q4 = lane >> 4;
    for (int rt = gwv; rt < TOK / 16; rt += nwv) {
        const bf16* ap = H + (size_t)(rt * 16 + li) * DM + q4 * 8;
        const bf16* bp = Wg + (size_t)li * DM + q4 * 8;
        f32x4 a0 = (f32x4){0.f, 0.f, 0.f, 0.f}, a1 = a0;
#pragma unroll 8
        for (int ks = 0; ks < DM / 32; ++ks) {
            const bf16x8 af = *(const bf16x8*)(ap + ks * 32);
            const bf16x8 b0 = *(const bf16x8*)(bp + ks * 32), b1 = *(const bf16x8*)(bp + (size_t)16 * DM + ks * 32);
            a0 = __builtin_amdgcn_mfma_f32_16x16x32_bf16(af, b0, a0, 0, 0, 0);
            a1 = __builtin_amdgcn_mfma_f32_16x16x32_bf16(af, b1, a1, 0, 0, 0);
        }
#pragma unroll
        for (int jj = 0; jj < 4; ++jj) {
            bf16* op = B.GM + (size_t)(rt * 16 + 4 * q4 + jj) * GMP + 6144 + li;
            const float rs = pg8::row_rscale(ssp, rt * 16 + 4 * q4 + jj);
            op[0] = (bf16)f2bf(a0[jj] * rs); op[16] = (bf16)f2bf(a1[jj] * rs);
        }
    }
}
__device__ __forceinline__ void unit_kmean(LAS unsigned char* lds, const Bufs& B, int item) {
    const int tid = ltid();
    const int j = item & 7, h = (item >> 3) & 7, b = item >> 6;
    LAS float* red = (LAS float*)lds;
    __syncthreads();
    const int d8 = tid & 15, tg = tid >> 4;
    float a[8];
#pragma unroll
    for (int e = 0; e < 8; ++e) a[e] = 0.f;
#pragma unroll
    for (int i = 0; i < 8; ++i) {
        const int t = 256 * j + tg + 32 * i;
        const v4u w = *(const v4u*)(B.P + hmo(b, 64 + h) + t * 128 + d8 * 8);
        a[0] += pg8::bf_lo(w.x); a[1] += pg8::bf_hi(w.x); a[2] += pg8::bf_lo(w.y); a[3] += pg8::bf_hi(w.y); a[4] += pg8::bf_lo(w.z); a[5] += pg8::bf_hi(w.z); a[6] += pg8::bf_lo(w.w); a[7] += pg8::bf_hi(w.w);
    }
#pragma unroll
    for (int e = 0; e < 8; ++e) red[tg * 128 + d8 * 8 + e] = a[e];
    __syncthreads();
    if (tid < 128) {
        float s = 0.f;
#pragma unroll 8
        for (int i = 0; i < 32; ++i) s += red[i * 128 + tid];
        B.KMEAN[(size_t)item * 128 + tid] = s * (1.0f / 256.0f);
    }
}
__device__ __forceinline__ void phase_dilmerge(const Bufs& B) {
    const int tid = ltid(), lane = tid & 63, wave = tid >> 6;
    const int gw = lbid() * 8 + wave, NGW = gridDim.x * 8;
    const int slot = lane >> 4, d8 = lane & 15;
    for (int row = gw; row < TOK; row += NGW) {
        float ls[3];
#pragma unroll
        for (int g = 0; g < 3; ++g) ls[g] = B.LSE[((size_t)g * TOK + row) * 4 + slot];
        const float mx = fmaxf(ls[0], fmaxf(ls[1], ls[2]));
        float w[3]; float sw = 0.f;
#pragma unroll
        for (int g = 0; g < 3; ++g) { w[g] = __expf(ls[g] - mx); sw += w[g]; }
        const float inv = 1.0f / sw;
        float a[8];
#pragma unroll
        for (int e = 0; e < 8; ++e) a[e] = 0.f;
#pragma unroll
        for (int g = 0; g < 3; ++g) {
            const v4u v = *(const v4u*)(B.OG + ((size_t)g * TOK + row) * 512 + slot * 128 + d8 * 8); const float ww = w[g] * inv;
            a[0] += ww * pg8::bf_lo(v.x); a[1] += ww * pg8::bf_hi(v.x); a[2] += ww * pg8::bf_lo(v.y); a[3] += ww * pg8::bf_hi(v.y);
            a[4] += ww * pg8::bf_lo(v.z); a[5] += ww * pg8::bf_hi(v.z); a[6] += ww * pg8::bf_lo(v.w); a[7] += ww * pg8::bf_hi(v.w);
        }
        v4u o; o.x = pk2(a[0], a[1]); o.y = pk2(a[2], a[3]); o.z = pk2(a[4], a[5]); o.w = pk2(a[6], a[7]);
        *(v4u*)(B.OB + (size_t)row * 2560 + slot * 128 + d8 * 8) = o;
    }
}

#define RLX_AGENT __ATOMIC_RELAXED, __HIP_MEMORY_SCOPE_AGENT
#define XB_TMO      128
#define XB_XCNT(j)  (256  + 64 * (j))
#define XB_XSUB(j)  (1280 + 64 * (j))
#define XB_XGEN(j)  (2304 + 64 * (j))
#define XB_TOP      3328
#define XB_TOPGEN   3392
#define XCD_BAR_WORDS 3456
#define XB_SPIN_CAP (1u << 18)

__device__ __forceinline__ unsigned xb_ld(unsigned* p)              { return __hip_atomic_load(p, __ATOMIC_RELAXED, __HIP_MEMORY_SCOPE_AGENT); }
__device__ __forceinline__ unsigned xb_add(unsigned* p, unsigned v) { return __hip_atomic_fetch_add(p, v, __ATOMIC_RELAXED, __HIP_MEMORY_SCOPE_AGENT); }
__device__ __forceinline__ unsigned xb_xcc_id() { return (unsigned)__builtin_amdgcn_s_getreg((3 << 11) | 20) & 0xFu; }
#define XB_SPIN(cond, bar) do { unsigned _sp = 0; while (cond) { __builtin_amdgcn_s_sleep(1); \
    if ((++_sp & 255u) == 0u) { if (xb_ld(&(bar)[XB_TMO])) break; if (_sp > XB_SPIN_CAP) { atomicAdd(&(bar)[XB_TMO], 1u); break; } } } } while (0)

struct XcdBarrier {
    unsigned* bar; unsigned x;
    volatile LAS unsigned* st;
};

__device__ __forceinline__ XcdBarrier xcd_barrier_post(unsigned* bar, volatile LAS unsigned* st) {
    XcdBarrier b; b.bar = bar; b.x = xb_xcc_id(); b.st = st;
    if (threadIdx.x == 0) (void)xb_add(&bar[XB_XCNT(b.x)], 1u);
    return b;
}
__device__ __forceinline__ void xcd_barrier_complete(unsigned* bar, unsigned x, unsigned& nloc, unsigned& nx) {
    const unsigned G = gridDim.x * gridDim.y * gridDim.z;
    unsigned sum, cnt, mine, sp = 0u;
    for (;;) {
        sum = 0u; cnt = 0u; mine = 0u;
#pragma unroll
        for (unsigned j = 0; j < 16; ++j) { const unsigned c = xb_ld(&bar[XB_XCNT(j)]); sum += c; cnt += (c > 0u) ? 1u : 0u; mine = (j == x) ? c : mine; }
        if (sum == G) break;
        __builtin_amdgcn_s_sleep(1);
        if ((++sp & 255u) == 0u) { if (xb_ld(&bar[XB_TMO])) break; if (sp > XB_SPIN_CAP) { atomicAdd(&bar[XB_TMO], 1u); break; } }
    }
    nloc = mine > 0u ? mine : 1u; nx = cnt > 0u ? cnt : 1u;
}

__device__ __forceinline__ void xcd_barrier(const XcdBarrier& b) {
    asm volatile("s_waitcnt vmcnt(0)" ::: "memory");
    __syncthreads();
    if (threadIdx.x == 0) {
        unsigned* bar = b.bar;
        __builtin_amdgcn_s_waitcnt(0);
        unsigned nloc = b.st[0], nx = b.st[1];
        if (nloc == 0u) { xcd_barrier_complete(bar, b.x, nloc, nx); b.st[0] = nloc; b.st[1] = nx; }
        const unsigned old = xb_add(&bar[XB_XSUB(b.x)], 1u);
        const unsigned gen = old / nloc;
        if (old + 1u == (gen + 1u) * nloc) {
            __builtin_amdgcn_fence(__ATOMIC_RELEASE, "agent");
            asm volatile("s_waitcnt vmcnt(0)" ::: "memory");
            const unsigned og = xb_add(&bar[XB_TOP], 1u);
            const unsigned tg = og / nx;
            if (og + 1u == (tg + 1u) * nx) xb_add(&bar[XB_TOPGEN], 1u);
            else XB_SPIN(xb_ld(&bar[XB_TOPGEN]) == tg, bar);
            __builtin_amdgcn_fence(__ATOMIC_ACQUIRE, "agent");
            xb_add(&bar[XB_XGEN(b.x)], 1u);
            asm volatile("s_waitcnt vmcnt(0)" ::: "memory");
        } else {
            XB_SPIN(xb_ld(&bar[XB_XGEN(b.x)]) == gen, bar);
            __builtin_amdgcn_fence(__ATOMIC_ACQUIRE, "agent");
            asm volatile("s_waitcnt vmcnt(0)" ::: "memory");
        }
    }
    __syncthreads();
}

__device__ __forceinline__ void panel_rscale(LAS float* rst, const float* ssp, int pm) {
    const int tid = ltid(), row = tid >> 1, half = tid & 1;
    const f32x4* pp = (const f32x4*)(ssp + (size_t)(pm * 256 + row) * 32 + half * 16);
    float sacc = 0.f;
#pragma unroll
    for (int i = 0; i < 4; ++i) { const f32x4 v = pp[i]; sacc += (v[0] + v[1]) + (v[2] + v[3]); }
    sacc += __shfl_xor(sacc, 1);
    if (half == 0) rst[row] = rsqrtf(sacc * (1.0f / 2048.0f) + 1e-6f);
    __syncthreads();
}
struct Args { const float* in[17]; float* out; unsigned char* ws; int lo, hi, coop, pad; };
constexpr int NPHASE = 22;

typedef const __attribute__((address_space(4))) Args* KArgs;
__device__ __forceinline__ KArgs kargs() { KArgs p = (KArgs)__builtin_amdgcn_kernarg_segment_ptr(); asm volatile("" : "+s"(p)); return p; }
__device__ __forceinline__ Bufs mk_bufs(unsigned char* ws) {
    Bufs B;
    B.P = (bf16*)(ws + WS_P); B.GM = (bf16*)(ws + WS_GM); B.QR = (bf16*)(ws + WS_QR); B.KC = (bf16*)(ws + WS_KC); B.VC = (bf16*)(ws + WS_VC);
    B.OA = (bf16*)(ws + WS_TMP); B.OC = B.OA + 1536; B.OG = (bf16*)(ws + WS_OG); B.OB = B.OA + 1024;
    B.KMEAN = (float*)(ws + WS_KMEAN); B.LSE = (float*)(ws + WS_LSE); B.SELM = (unsigned*)(ws + WS_SELM);
    return B;
}
__global__ void __launch_bounds__(512, 2) mk_fwd(Args args_unused) {
    extern __shared__ __attribute__((aligned(16))) unsigned char lds_raw[];
    LAS unsigned char* lds = (LAS unsigned char*)lds_raw;
    cg::grid_group grid = cg::this_grid();
    const int lo = kargs()->lo, hi = kargs()->hi, coop = kargs()->coop;
    volatile LAS unsigned* xst = (volatile LAS unsigned*)(lds + LDS_BYTES - 64);
    if (threadIdx.x < 4) xst[threadIdx.x] = 0u;
    __syncthreads();
    XcdBarrier xbar; xbar.bar = (unsigned*)(kargs()->ws + WS_CTL); xbar.x = 0; xbar.st = nullptr;
    if (coop) xbar = xcd_barrier_post((unsigned*)(kargs()->ws + WS_CTL), xst);
    const int G = gridDim.x;
#define IN(k) (lo <= (k) && (k) < hi)
#define SEAM(k) do { if (coop && (k) + 1 < hi) { if (hi > NPHASE) grid.sync(); else xcd_barrier(xbar); } } while (0)

    if (IN(0)) {
        KArgs ka = kargs(); const int bid = lbid(); (void)bid; Ctx C;
#pragma unroll
        for (int i = 0; i < 17; ++i) C.in[i] = ka->in[i];
        C.out = ka->out; C.ws = ka->ws;
        for (int rep_ = 0; rep_ < 1 + (DUPMASK & 1); ++rep_) phase_prep(C, lds, rep_ == 0);
        phase_cast(C.in[0], (bf16*)(C.ws + WS_H), (float*)(C.ws + WS_SSP));
        SEAM(0);
    }

#pragma unroll 1
    for (int l = 0; l < NLAYER; ++l) {
        const int pb = 1 + 10 * l;
        if (IN(pb + 1)) {
          for (int rep_ = 0; rep_ < 1 + ((DUPMASK >> 2) & 1); ++rep_) {
            KArgs ka = kargs(); const int bid = lbid(); (void)bid; unsigned char* ws = ka->ws;
            pg8::Gemm g{(const bf16*)(ws + WS_H), (const bf16*)(ws + WS_WIN) + (size_t)l * PITCH * DM, TOK, 16384, DM}; pg8::StaticOrder S; S.init(TOK, 16384, G, bid);
            const float* ssp_ = (const float*)(ws + WS_SSP) + (size_t)(2 * l) * TOK * 32;
            LAS float* rst = (LAS float*)(lds + 131072 + 1024);
            pg8::Unit u0; const int pm0 = S.next(0, u0) ? u0.pm : 0;
            panel_rscale(rst, ssp_, pm0);
            pg8::EpiInProj E{(bf16*)(ws + WS_P), (bf16*)(ws + WS_QR), (bf16*)(ws + WS_GM), (const float*)(ws + WS_ROPE), rst};
            pg8::gemm_phase<pg8::EpiInProj, pg8::StaticOrder, true, true>(lds, g, S, E);
            }
            SEAM(pb + 1);
        }
        if (IN(pb + 2)) {
          for (int rep_ = 0; rep_ < 1 + ((DUPMASK >> 3) & 1); ++rep_) {
            KArgs ka = kargs(); const int bid = lbid(); (void)bid; unsigned char* ws = ka->ws; const Bufs B = mk_bufs(ws);
            for (int task = bid; task < 64; task += G) {
                const int kv = task & 1, rt = task >> 1;
                unit_compress(lds, B, (const bf16*)(ws + WS_W1T) + (size_t)(l * 2 + kv) * 256 * 4096, (const bf16*)(ws + WS_W2T) + (size_t)(l * 2 + kv) * 128 * 256,
                              (const float*)(ws + WS_BIASP) + (size_t)(l * 2 + kv) * 32 * 256, kv, rt);
            }
            for (int item = (bid + 128) % G; item < 256; item += G) unit_kmean(lds, B, item);
            {
                const int wv = ltid() >> 6, gwv = ((bid + G / 2) % G) * 8 + wv;
                gate_gemm(B, (const bf16*)(ws + WS_H), (const bf16*)(ws + WS_WIN) + (size_t)l * PITCH * DM + (size_t)16384 * DM, (const float*)(ws + WS_SSP) + (size_t)(2 * l) * TOK * 32, gwv, G * 8);
            }
            {
                unsigned* qc = (unsigned*)(ws + WS_QCTR) + 64 * l;
                LAS unsigned* qs = (LAS unsigned*)(lds + LDS_BYTES - 32);
                for (;;) {
                    __syncthreads();
                    if (ltid() == 0) qs[0] = __hip_atomic_fetch_add(qc, 1u, __ATOMIC_RELAXED, __HIP_MEMORY_SCOPE_AGENT);
                    __syncthreads();
                    const int u = (int)qs[0];
                    if (u >= 512) break;
                    if (u < 128) unit_dilated<2>(lds, B, 0, 1, u >> 5, (u >> 3) & 3, 0, (u & 7) * 256);
                    else if (u < 256) { const int v = u - 128; unit_dilated<2>(lds, B, 1, 4, v >> 5, (v >> 3) & 3, (v >> 1) & 3, (v & 1) * 256); }
                    else { const int v = u - 256; unit_dilated<1>(lds, B, 2, 16, v >> 6, (v >> 4) & 3, v & 15, 0); }
                }
            }
            }
            SEAM(pb + 2);
        }
        if (IN(pb + 4)) {
          for (int rep_ = 0; rep_ < 1 + ((DUPMASK >> 5) & 1); ++rep_) {
            { KArgs ka = kargs(); const int bid = lbid(); (void)bid; const Bufs B = mk_bufs(ka->ws);
              for (int u = bid; u < 256; u += G) unit_cmp(lds, B, u); }
            asm volatile("s_waitcnt vmcnt(0)" ::: "memory"); __syncthreads();
            { KArgs ka = kargs(); const int bid = lbid(); (void)bid; const Bufs B = mk_bufs(ka->ws);
              for (int u = bid; u < 256; u += G) unit_nsa(lds, B, u); }
            for (int rep2_ = 0; rep2_ < 1 + ((DUPMASK >> 12) & 1); ++rep2_)
            { KArgs ka = kargs(); const int bid = lbid(); (void)bid; const Bufs B = mk_bufs(ka->ws);
              for (int u = bid; u < 256; u += G) { const int q_blk = u & 31, g = (u >> 5) & 1, b = u >> 6; unit_moba(lds, B, b, (q_blk & 3) * 2 + g, 7 - (q_blk >> 2)); } }
            { KArgs ka = kargs(); const int bid = lbid(); (void)bid; const Bufs B = mk_bufs(ka->ws); phase_dilmerge(B); }
            }
            SEAM(pb + 4);
        }
        if (IN(pb + 5)) {
          for (int rep_ = 0; rep_ < 1 + ((DUPMASK >> 6) & 1); ++rep_) {
            { KArgs ka = kargs(); const int bid = lbid(); unsigned char* ws = ka->ws;
              pg8::StaticOrder S; S.init(TOK, DM, G, bid);
              pg8::Gemm g{(const bf16*)(ws + WS_TMP), (const bf16*)(ws + WS_WBA) + (size_t)l * DM * 2560, TOK, DM, 2560};
              pg8::EpiBranchF E{(const bf16*)(ws + WS_GM), (bf16*)(ws + WS_MG)};
              pg8::gemm_phase<pg8::EpiBranchF, pg8::StaticOrder, true, true>(lds, g, S, E); }
            }
            SEAM(pb + 5);
        }
        if (IN(pb + 6)) {
          for (int rep_ = 0; rep_ < 1 + ((DUPMASK >> 7) & 1); ++rep_) {
            KArgs ka = kargs(); const int bid = lbid(); (void)bid; unsigned char* ws = ka->ws;
            const float* xin = (l == 0) ? ka->in[0] : (const float*)(ws + WS_X2);
            pg8::Gemm g{(const bf16*)(ws + WS_MG), (const bf16*)(ws + WS_WO) + (size_t)l * DM * DM, TOK, DM, DM}; pg8::StaticOrder S; S.init(TOK, DM, G, bid);
            pg8::EpiResid E{xin, (float*)(ws + WS_X1), (bf16*)(ws + WS_H), (float*)(ws + WS_SSP) + (size_t)(2 * l + 1) * TOK * 32};
            pg8::gemm_phase<pg8::EpiResid, pg8::StaticOrder, true, true>(lds, g, S, E);
            }
            SEAM(pb + 6);
        }
        if (IN(pb + 8)) {
          for (int rep_ = 0; rep_ < 1 + ((DUPMASK >> 9) & 1); ++rep_) {
            KArgs ka = kargs(); const int bid = lbid(); (void)bid; unsigned char* ws = ka->ws;
            pg8::Gemm g{(const bf16*)(ws + WS_H), (const bf16*)(ws + WS_WMI) + (size_t)l * DFF * DM, TOK, DFF, DM}; pg8::StaticOrder S; S.init(TOK, DFF, G, bid);
            const float* ssp_ = (const float*)(ws + WS_SSP) + (size_t)(2 * l + 1) * TOK * 32;
            LAS float* rst = (LAS float*)(lds + 131072 + 1024);
            pg8::Unit u0; const int pm0 = S.next(0, u0) ? u0.pm : 0;
            panel_rscale(rst, ssp_, pm0);
            pg8::EpiRelu2 E{(bf16*)(ws + WS_U), rst};
            pg8::gemm_phase<pg8::EpiRelu2, pg8::StaticOrder, true, true>(lds, g, S, E);
            }
            SEAM(pb + 8);
        }
        if (IN(pb + 9)) {
          for (int rep_ = 0; rep_ < 1 + ((DUPMASK >> 10) & 1); ++rep_) {
            KArgs ka = kargs(); const int bid = lbid(); (void)bid; unsigned char* ws = ka->ws;
            pg8::Gemm g{(const bf16*)(ws + WS_U), (const bf16*)(ws + WS_WMO) + (size_t)l * DM * DFF, TOK, DM, DFF}; pg8::StaticOrder S; S.init(TOK, DM, G, bid);
            pg8::EpiResid E{(const float*)(ws + WS_X1), (float*)(ws + WS_X2), (bf16*)(ws + WS_H), (float*)(ws + WS_SSP) + (size_t)(2 * l + 2) * TOK * 32};
            pg8::gemm_phase<pg8::EpiResid, pg8::StaticOrder, true, true>(lds, g, S, E);
            }
            SEAM(pb + 9);
        }
    }
    if (IN(21)) { KArgs ka = kargs(); const int bid = lbid(); (void)bid; phase_final((const float*)(ka->ws + WS_X2), ka->in[16], (const float*)(ka->ws + WS_SSP) + (size_t)4 * TOK * 32, ka->out); }
#undef IN
#undef SEAM
}

#ifndef DUPMASK
#define DUPMASK 0
#endif
#ifndef MK_RUN_PHASES
#define MK_RUN_PHASES NPHASE
#endif
#ifndef MK_MULTI
#define MK_MULTI 0
#endif
extern "C" void kernel_launch(void* const* d_in, const int* in_sizes, int n_in, void* d_out, int out_size, void* d_ws, size_t ws_size, hipStream_t stream) {
    static int grid = 0;
    if (grid == 0) {
        if (n_in != 17 || out_size != TOK * DM || ws_size < WS_END) { fprintf(stderr, "kernel_launch: unexpected shapes (n_in %d out %d ws %zu need %zu)\n", n_in, out_size, ws_size, (size_t)WS_END); grid = -1; return; }
        int dev = 0, cus = 0, per_cu = 0;
        hipGetDevice(&dev); hipDeviceGetAttribute(&cus, hipDeviceAttributeMultiprocessorCount, dev);
        if (hipFuncSetAttribute((const void*)mk_fwd, hipFuncAttributeMaxDynamicSharedMemorySize, LDS_BYTES) != hipSuccess) { fprintf(stderr, "kernel_launch: hipFuncSetAttribute failed\n"); grid = -1; return; }
        hipOccupancyMaxActiveBlocksPerMultiprocessor(&per_cu, (const void*)mk_fwd, 512, LDS_BYTES);
        (void)hipGetLastError();
        if (per_cu < 1) per_cu = 1;
        grid = cus * 1;
        if (grid != 256) { fprintf(stderr, "kernel_launch: this kernel assumes a 256-CU device (got %d)\n", cus); grid = 256; }
    }
    if (grid < 0) return;
    hipMemsetAsync((char*)d_ws, 0, 131072, stream);
    Args a{};
    for (int i = 0; i < 17; ++i) a.in[i] = (const float*)d_in[i];
    a.out = (float*)d_out; a.ws = (unsigned char*)d_ws;
#if MK_MULTI
    for (int p = 0; p < MK_RUN_PHASES; ++p) {
        a.lo = p; a.hi = p + 1; a.coop = 0;
        hipLaunchKernelGGL(mk_fwd, dim3(grid), dim3(512), LDS_BYTES, stream, a);
    }
#else
    a.lo = 0; a.hi = NPHASE; a.coop = 1;
    void* kargs[] = {&a};
    hipError_t e = hipLaunchCooperativeKernel((const void*)mk_fwd, dim3(grid), dim3(512), kargs, LDS_BYTES, stream);
    if (e != hipSuccess) fprintf(stderr, "cooperative launch failed: %s (grid %d)\n", hipGetErrorString(e), grid);
#endif
}
```

```cpp
#include <hip/hip_runtime.h>
#include <hip/hip_cooperative_groups.h>
#include <cstdio>
#include <cstdint>
namespace cg = cooperative_groups;
namespace pg8 {
#define PG8_LAS __attribute__((address_space(3)))
typedef unsigned short bf16_t;
typedef short bf16x8 __attribute__((ext_vector_type(8)));
typedef float f32x4 __attribute__((ext_vector_type(4)));
typedef unsigned u32x4 __attribute__((ext_vector_type(4)));
constexpr int BM = 256, BK = 64, HALF = 128, HTB = HALF * BK * 2  , STAGE_BYTES = 8 * HTB, NXCD = 8, WGM = 4;

__host__ __device__ __forceinline__ int lds_byte(int r, int c) { const int st = (r >> 4) * 2 + (c >> 5), rr = r & 15, cc = c & 31, ob = rr * 64 + cc * 2; return st * 1024 + (ob ^ (((ob >> 9) & 1) << 5)); }
__host__ __device__ __forceinline__ void stage_rc(int b, int& R, int& C) { const int st = b / 1024, sb = b % 1024, swz = sb ^ (((sb >> 9) & 1) << 5); R = (st >> 1) * 16 + swz / 64; C = (st & 1) * 32 + (swz % 64) / 2; }
__host__ __device__ __forceinline__ int perm32(int rho) { const int n = rho >> 4, i = rho & 15; return 8 * (i >> 2) + 4 * n + (i & 3); }

struct Unit { int pm, pn; };
struct Gemm { const bf16_t* A; const bf16_t* Bt; int M, N, K; };

struct StaticOrder {
    int nM, nN, nwg, G, c;
    __host__ __device__ void init(int M, int N, int G_, int c_) { nM = M / BM; nN = N / BM; nwg = nM * nN; G = G_; c = c_; }
    __host__ __device__ __forceinline__ bool next(int i, Unit& u) const {
        const long L = (long)i * G + c; if (L >= nwg) return false;
        int wgid = (int)L; { const int q = nwg / NXCD, r = nwg % NXCD, xcd = wgid % NXCD, off = wgid / NXCD; wgid = (xcd < r ? xcd * (q + 1) : r * (q + 1) + (xcd - r) * q) + off; }
        const int nig = WGM * nN, gid = wgid / nig, fm = gid * WGM, gsz = (nM - fm) < WGM ? (nM - fm) : WGM;
        u.pm = fm + ((wgid % nig) % gsz); u.pn = (wgid % nig) / gsz; return true;
    }
    __device__ __forceinline__ void a_ready(const Unit&) const {}
    __device__ __forceinline__ void done(const Unit&) const {}
};


__device__ __forceinline__ unsigned cvt_pk_bf16(float lo, float hi) { unsigned r; asm volatile("v_cvt_pk_bf16_f32 %0, %1, %2" : "=v"(r) : "v"(lo), "v"(hi)); return r; }
typedef unsigned u32x2 __attribute__((ext_vector_type(2)));
__device__ __forceinline__ float bf_lo(unsigned w) { return __uint_as_float(w << 16); }
__device__ __forceinline__ float bf_hi(unsigned w) { return __uint_as_float(w & 0xffff0000u); }
__device__ __forceinline__ float sigmoidf_(float x) { return 1.0f / (1.0f + __expf(-x)); }
__device__ __forceinline__ void store8bf(bf16_t* p, f32x4 v0, f32x4 v1) {
    u32x4 w; w.x = cvt_pk_bf16(v0[0], v0[1]); w.y = cvt_pk_bf16(v0[2], v0[3]); w.z = cvt_pk_bf16(v1[0], v1[1]); w.w = cvt_pk_bf16(v1[2], v1[3]);
    *(u32x4*)p = w;
}

constexpr int IP_PITCH = 16640, GM_PITCH = 6400, NHM = 80;
__device__ __forceinline__ float row_rscale(const float* ssp, int row) {
    const f32x4* pp = (const f32x4*)(ssp + (size_t)row * 32);
    float s = 0.f;
#pragma unroll
    for (int i = 0; i < 8; ++i) { const f32x4 v = pp[i]; s += (v[0] + v[1]) + (v[2] + v[3]); }
    return rsqrtf(s * (1.0f / 2048.0f) + 1e-6f);
}
struct EpiInProj {
    static constexpr bool HAS_MID = false; static constexpr int T1 = -1, T2 = -1; static constexpr bool PERM = true, AFTER_DRAIN = false;
    bf16_t* HM; bf16_t* QR; bf16_t* GM; const float* rope; const PG8_LAS float* rst;
    __device__ __forceinline__ bool rope_seg(int cb) const { return cb < 1024 || (cb >= 1536 && cb < 1792) || (cb >= 2048 && cb < 2304) || (cb >= 2560 && cb < 5632) || (cb >= 7168 && cb < 9216); }
    __device__ __forceinline__ void operator()(const f32x4 (&acc)[2][2][4][2], const Unit& u, int wr, int wc, int fr, int fq) const {
        const int row0 = u.pm * BM + wr * 64 + fr, cin = wc * 32 + 8 * fq;
        const int cb0 = u.pn * BM, cb1 = cb0 + HALF;
        const bool rot0 = rope_seg(cb0) && (wc == 0), rot1 = rope_seg(cb1) && (wc == 0);
        const f32x4 k0 = (fq & 1) ? (f32x4){0.00022507907903927653f, 9.911730936901935e-05f, 4.364795279280289e-05f, 1.9221100684944863e-05f} : (f32x4){0.15915494309189535f, 0.0700865215877985f, 0.03086376340470123f, 0.013591370636193905f};
        const f32x4 k1 = (fq & 1) ? (f32x4){8.464330808241401e-06f, 3.727408601915352e-06f, 1.6414262627950345e-06f, 7.228293068832865e-07f} : (f32x4){0.005985185712713705f, 0.002635675898667414f, 0.001160663641240061f, 0.0005111175045375439f};
        const float sg = (fq < 2) ? -1.0f : 1.0f;
#pragma unroll
        for (int ai = 0; ai < 2; ++ai)
#pragma unroll
            for (int m = 0; m < 4; ++m) {
                const int row = row0 + ai * HALF + m * 16, b = row >> 11, t = row & 2047;
                const float rs = rst[wr * 64 + fr + ai * HALF + m * 16];
                f32x4 c0, c1, s0, s1;
                if (rot0 || rot1) {
                    const float tf = (float)t;
#pragma unroll
                    for (int e = 0; e < 4; ++e) {
                        const float r0 = __builtin_amdgcn_fractf(tf * k0[e]), r1 = __builtin_amdgcn_fractf(tf * k1[e]);
                        c0[e] = __builtin_amdgcn_cosf(r0); s0[e] = __builtin_amdgcn_sinf(r0) * sg; c1[e] = __builtin_amdgcn_cosf(r1); s1[e] = __builtin_amdgcn_sinf(r1) * sg;
                    }
                }
#pragma unroll
                for (int bj = 0; bj < 2; ++bj) {
                    const int cb = bj ? cb1 : cb0;
                    const bool isq = cb < 1024, ishm = cb < 10240, rot = bj ? rot1 : rot0;
                    const int hidx = cb >> 7;
                    f32x4 v0 = acc[ai][bj][m][0] * rs, v1 = acc[ai][bj][m][1] * rs;
                    bf16_t* hp = HM + ((((size_t)(b * NHM + hidx)) * 2048 + t) << 7) + cin;
                    if (isq) store8bf(hp, v0, v1);
                    if (rot) {
                        f32x4 p0, p1;
#pragma unroll
                        for (int e = 0; e < 4; ++e) { p0[e] = __shfl_xor(v0[e], 32); p1[e] = __shfl_xor(v1[e], 32); }
                        v0 = v0 * c0 + p0 * s0; v1 = v1 * c1 + p1 * s1;
                    }
                    bf16_t* dst = isq ? (QR + ((((size_t)(b * 8 + hidx)) * 2048 + t) << 7) + cin) : (ishm ? hp : (GM + (size_t)row * GM_PITCH + (cb - 10240) + cin));
                    store8bf(dst, v0, v1);
                }
            }
    }
};
template <int MODE> struct EpiBranch {
    static constexpr bool HAS_MID = false; static constexpr int T1 = -1, T2 = -1; static constexpr bool PERM = false, AFTER_DRAIN = false;
    const bf16_t* GM; int gcol; float* TMP; bf16_t* MG;
    __device__ __forceinline__ void operator()(const f32x4 (&acc)[2][2][4][2], const Unit& u, int wr, int wc, int fr, int fq) const {
        const int row0 = u.pm * BM + wr * 64 + fr, col0 = u.pn * BM + wc * 32 + 4 * fq;
#pragma unroll
        for (int ai = 0; ai < 2; ++ai)
#pragma unroll
            for (int m = 0; m < 4; ++m) {
                const int row = row0 + ai * HALF + m * 16;
#pragma unroll
                for (int bj = 0; bj < 2; ++bj)
#pragma unroll
                    for (int n = 0; n < 2; ++n) {
                        const int col = col0 + bj * HALF + n * 16;
                        const u32x2 mr = *(const u32x2*)(GM + (size_t)row * GM_PITCH + gcol + col);
                        f32x4 sg; sg[0] = sigmoidf_(bf_lo(mr.x)); sg[1] = sigmoidf_(bf_hi(mr.x)); sg[2] = sigmoidf_(bf_lo(mr.y)); sg[3] = sigmoidf_(bf_hi(mr.y));
                        f32x4 val = acc[ai][bj][m][n] * sg;
                        float* tp = TMP + (size_t)row * 2048 + col;
                        if (MODE == 0) { *(f32x4*)tp = val; }
                        else if (MODE == 1) { *(f32x4*)tp = *(const f32x4*)tp + val; }
                        else { val = val + *(const f32x4*)tp; u32x2 w; w.x = cvt_pk_bf16(val[0], val[1]); w.y = cvt_pk_bf16(val[2], val[3]); *(u32x2*)(MG + (size_t)row * 2048 + col) = w; }
                    }
                asm volatile("" ::: "memory");
            }
    }
};
struct EpiBranchF {
    static constexpr bool HAS_MID = true; static constexpr int T1 = 16, T2 = 24; static constexpr bool PERM = false, AFTER_DRAIN = false;
    const bf16_t* GM; bf16_t* MG;
    __device__ __forceinline__ void mid(f32x4 (&acc)[2][2][4][2], const Unit& u, int t, int wr, int wc, int fr, int fq) const {
        const int gx = (t == T1) ? 0 : 2048;
        int fr_ = fr, fq_ = fq; asm volatile("" : "+v"(fr_), "+v"(fq_));
        const int row0 = u.pm * BM + wr * 64 + fr_, col0 = u.pn * BM + wc * 32 + 4 * fq_;
#pragma unroll
        for (int ai = 0; ai < 2; ++ai)
#pragma unroll
            for (int m = 0; m < 4; ++m) {
                const bf16_t* gp = GM + (size_t)(row0 + ai * HALF + m * 16) * GM_PITCH + gx + col0;
#pragma unroll
                for (int bj = 0; bj < 2; ++bj)
#pragma unroll
                    for (int n = 0; n < 2; ++n) {
                        const u32x2 mx = *(const u32x2*)(gp + bj * HALF + n * 16), my = *(const u32x2*)(gp + 2048 + bj * HALF + n * 16);
                        f32x4 r;
                        r[0] = (1.0f + __expf(-bf_lo(my.x))) * __builtin_amdgcn_rcpf(1.0f + __expf(-bf_lo(mx.x))); r[1] = (1.0f + __expf(-bf_hi(my.x))) * __builtin_amdgcn_rcpf(1.0f + __expf(-bf_hi(mx.x)));
                        r[2] = (1.0f + __expf(-bf_lo(my.y))) * __builtin_amdgcn_rcpf(1.0f + __expf(-bf_lo(mx.y))); r[3] = (1.0f + __expf(-bf_hi(my.y))) * __builtin_amdgcn_rcpf(1.0f + __expf(-bf_hi(mx.y)));
                        acc[ai][bj][m][n] = acc[ai][bj][m][n] * r;
                        if (n == 1) asm volatile("" ::: "memory");
                    }
            }
    }
    __device__ __forceinline__ void operator()(const f32x4 (&acc)[2][2][4][2], const Unit& u, int wr, int wc, int fr, int fq) const {
        const int row0 = u.pm * BM + wr * 64 + fr, col0 = u.pn * BM + wc * 32 + 4 * fq;
#pragma unroll
        for (int ai = 0; ai < 2; ++ai)
#pragma unroll
            for (int m = 0; m < 4; ++m) {
                const int row = row0 + ai * HALF + m * 16;
#pragma unroll
                for (int bj = 0; bj < 2; ++bj)
#pragma unroll
                    for (int n = 0; n < 2; ++n) {
                        const int col = col0 + bj * HALF + n * 16;
                        const u32x2 mr = *(const u32x2*)(GM + (size_t)row * GM_PITCH + 4096 + col);
                        f32x4 sg; sg[0] = sigmoidf_(bf_lo(mr.x)); sg[1] = sigmoidf_(bf_hi(mr.x)); sg[2] = sigmoidf_(bf_lo(mr.y)); sg[3] = sigmoidf_(bf_hi(mr.y));
                        const f32x4 val = acc[ai][bj][m][n] * sg;
                        u32x2 w; w.x = cvt_pk_bf16(val[0], val[1]); w.y = cvt_pk_bf16(val[2], val[3]); *(u32x2*)(MG + (size_t)row * 2048 + col) = w;
                    }
                if (m & 1) asm volatile("" ::: "memory");
            }
    }
};
struct EpiResid {
    static constexpr bool HAS_MID = false; static constexpr int T1 = -1, T2 = -1; static constexpr bool PERM = false, AFTER_DRAIN = false;
    const float* base; float* out; bf16_t* xb; float* ssp;
    __device__ __forceinline__ void operator()(const f32x4 (&acc)[2][2][4][2], const Unit& u, int wr, int wc, int fr, int fq) const {
        const int row0 = u.pm * BM + wr * 64 + fr, col0 = u.pn * BM + wc * 32 + 4 * fq;
#pragma unroll
        for (int ai = 0; ai < 2; ++ai) {
            f32x4 bs[4][2][2];
#pragma unroll
            for (int m = 0; m < 4; ++m)
#pragma unroll
                for (int bj = 0; bj < 2; ++bj)
#pragma unroll
                    for (int n = 0; n < 2; ++n) bs[m][bj][n] = *(const f32x4*)(base + (size_t)(row0 + ai * HALF + m * 16) * 2048 + col0 + bj * HALF + n * 16);
            asm volatile("" ::: "memory");
#pragma unroll
            for (int m = 0; m < 4; ++m) {
                const int row = row0 + ai * HALF + m * 16;
                const size_t off = (size_t)row * 2048 + col0;
                float ss = 0.f;
#pragma unroll
                for (int bj = 0; bj < 2; ++bj)
#pragma unroll
                    for (int n = 0; n < 2; ++n) {
                        const size_t o2 = off + bj * HALF + n * 16; const f32x4 v = bs[m][bj][n] + acc[ai][bj][m][n];
                        *(f32x4*)(out + o2) = v; ss += (v[0] * v[0] + v[1] * v[1]) + (v[2] * v[2] + v[3] * v[3]);
                        u32x2 w; w.x = cvt_pk_bf16(v[0], v[1]); w.y = cvt_pk_bf16(v[2], v[3]); *(u32x2*)(xb + o2) = w;
                    }
                ss += __shfl_xor(ss, 16); ss += __shfl_xor(ss, 32);
                if (fq == 0) ssp[(size_t)row * 32 + u.pn * 4 + wc] = ss;
            }
            asm volatile("" ::: "memory");
        }
    }
};
struct EpiRelu2 {
    static constexpr bool HAS_MID = false; static constexpr int T1 = -1, T2 = -1; static constexpr bool PERM = true, AFTER_DRAIN = false;
    bf16_t* U; const PG8_LAS float* rst;
    __device__ __forceinline__ void operator()(const f32x4 (&acc)[2][2][4][2], const Unit& u, int wr, int wc, int fr, int fq) const {
        const int row0 = u.pm * BM + wr * 64 + fr, col0 = u.pn * BM + wc * 32 + 8 * fq;
#pragma unroll
        for (int ai = 0; ai < 2; ++ai)
#pragma unroll
            for (int m = 0; m < 4; ++m) {
                bf16_t* rowp = U + (size_t)(row0 + ai * HALF + m * 16) * 8192 + col0;
                const float rs = rst[wr * 64 + fr + ai * HALF + m * 16];
#pragma unroll
                for (int bj = 0; bj < 2; ++bj) {
                    f32x4 v0 = acc[ai][bj][m][0], v1 = acc[ai][bj][m][1];
#pragma unroll
                    for (int e = 0; e < 4; ++e) { const float a = fmaxf(v0[e], 0.f) * rs, b = fmaxf(v1[e], 0.f) * rs; v0[e] = a * a; v1[e] = b * b; }
                    store8bf(rowp + bj * HALF, v0, v1);
                }
            }
    }
};

template <class Epi, class Sched, bool ALIGN_EPI = false, bool SP2 = false>
__device__ __forceinline__ void gemm_phase(PG8_LAS unsigned char* lds, const Gemm g, const Sched& S, const Epi& E) {
    int tid_ = threadIdx.x; asm volatile("" : "+v"(tid_)); const int tid = tid_, wid = __builtin_amdgcn_readfirstlane(tid >> 6), lane = tid & 63, wr = wid >> 2, wc = wid & 3, fr = lane & 15, fq = lane >> 4;
    const int K = g.K, nt = K / BK;
    unsigned voffA[2], voffB[2];
#pragma unroll
    for (int i = 0; i < 2; ++i) { int R, C; stage_rc(tid * 16 + i * 8192, R, C); const int Rb = Epi::PERM ? ((R & ~31) + perm32(R & 31)) : R;
        voffA[i] = (unsigned)(R * K + C) * 2u; voffB[i] = (unsigned)(Rb * K + C) * 2u; }
    const size_t kstep = (size_t)(BK * 2);
    const size_t hstep = (size_t)HALF * K * 2;
    const size_t tstep = 2 * hstep;
    const unsigned ldsw = (unsigned)wid * 1024u;
    const int aoff = lds_byte(wr * 64 + fr, fq * 8), boff = lds_byte(wc * 32 + fr, fq * 8);
#define PG8_SA(b, h) (((b) * 2 + (h)) * HTB)
#define PG8_SB(b, h) ((4 + (b) * 2 + (h)) * HTB)
#define PG8_STAGE(bufoff, gbase, voff) do { _Pragma("unroll") for (int _i = 0; _i < 2; ++_i) \
        __builtin_amdgcn_global_load_lds((const unsigned*)((const char*)(gbase) + (voff)[_i]), (PG8_LAS unsigned*)(lds + (bufoff) + ldsw + _i * 8192), 16, 0, 0); } while (0)
#define PG8_LDA(dst, b, h) do { _Pragma("unroll") for (int m = 0; m < 4; ++m) _Pragma("unroll") for (int k = 0; k < 2; ++k) dst[m][k] = *(const PG8_LAS bf16x8*)(lds + PG8_SA(b, h) + aoff + m * 2048 + k * 1024); } while (0)
#define PG8_LDB(dst, b, h) do { _Pragma("unroll") for (int n = 0; n < 2; ++n) _Pragma("unroll") for (int k = 0; k < 2; ++k) dst[n][k] = *(const PG8_LAS bf16x8*)(lds + PG8_SB(b, h) + boff + n * 2048 + k * 1024); } while (0)
#define PG8_MMA(ai, bj, At, Bt) do { __builtin_amdgcn_s_setprio(1); _Pragma("unroll") for (int m = 0; m < 4; ++m) _Pragma("unroll") for (int n = 0; n < 2; ++n) _Pragma("unroll") for (int k = 0; k < 2; ++k) \
        acc[ai][bj][m][n] = __builtin_amdgcn_mfma_f32_16x16x32_bf16(Bt[n][k], At[m][k], acc[ai][bj][m][n], 0, 0, 0); __builtin_amdgcn_s_setprio(0); } while (0)
#define PG8_WAIT_V(n) asm volatile("s_waitcnt vmcnt(" #n ")" ::: "memory")
#define PG8_WAIT_L(n) asm volatile("s_waitcnt lgkmcnt(" #n ")" ::: "memory")
#define PG8_BAR __builtin_amdgcn_s_barrier()
#define PG8_SCHED __builtin_amdgcn_sched_barrier(0)
    Unit cur, nxt; int ui = 0;
    if (!S.next(0, cur)) return;
    f32x4 acc[2][2][4][2];
#pragma unroll
    for (int a = 0; a < 2; ++a)
#pragma unroll
        for (int b = 0; b < 2; ++b)
#pragma unroll
            for (int m = 0; m < 4; ++m)
#pragma unroll
                for (int n = 0; n < 2; ++n) acc[a][b][m][n] = (f32x4){0.f, 0.f, 0.f, 0.f};
    bf16x8 At[4][2], B0[2][2], B1[2][2];
    const char* cA = (const char*)g.A + (size_t)cur.pm * tstep; const char* cB = (const char*)g.Bt + (size_t)cur.pn * tstep;
    S.a_ready(cur);
    if constexpr (SP2) {
        PG8_STAGE(PG8_SB(0, 0), cB, voffB); PG8_STAGE(PG8_SB(0, 1), cB + hstep, voffB); PG8_STAGE(PG8_SA(0, 0), cA, voffA); PG8_STAGE(PG8_SA(0, 1), cA + hstep, voffA);
        if (wr == 1) PG8_BAR;
        PG8_WAIT_V(2); PG8_BAR;
        PG8_STAGE(PG8_SB(1, 0), cB + kstep, voffB); PG8_STAGE(PG8_SA(1, 0), cA + kstep, voffA); PG8_STAGE(PG8_SB(1, 1), cB + hstep + kstep, voffB);
        PG8_WAIT_V(6); PG8_BAR;
    } else {
        PG8_STAGE(PG8_SB(0, 0), cB, voffB); PG8_STAGE(PG8_SA(0, 0), cA, voffA); PG8_STAGE(PG8_SB(0, 1), cB + hstep, voffB); PG8_STAGE(PG8_SA(0, 1), cA + hstep, voffA);
        if (wr == 1) PG8_BAR;
        PG8_WAIT_V(4); PG8_BAR;
        PG8_STAGE(PG8_SB(1, 0), cB + kstep, voffB); PG8_STAGE(PG8_SA(1, 0), cA + kstep, voffA); PG8_STAGE(PG8_SB(1, 1), cB + hstep + kstep, voffB);
        PG8_WAIT_V(6); PG8_BAR;
    }
    for (;;) {
        const bool has_next = S.next(ui + 1, nxt);
        const char* nA = has_next ? (const char*)g.A + (size_t)nxt.pm * tstep : cA; const char* nB = has_next ? (const char*)g.Bt + (size_t)nxt.pn * tstep : cB;
        for (int t = 0; t < nt; t += 2) {
            if constexpr (Epi::HAS_MID) { if (t == Epi::T1 || t == Epi::T2) E.mid(acc, cur, t, wr, wc, fr, fq); }
            const bool last = (t == nt - 2);
            const char* a1 = cA + (size_t)(t + 1) * kstep;
            const char* a2 = last ? nA : cA + (size_t)(t + 2) * kstep; const char* b2 = last ? nB : cB + (size_t)(t + 2) * kstep;
            const char* a3 = a2 + kstep; const char* b3 = b2 + kstep;
            if (last && has_next) S.a_ready(nxt);
            if constexpr (SP2) {
            PG8_LDB(B0, 0, 0); PG8_LDB(B1, 0, 1); PG8_SCHED; PG8_LDA(At, 0, 0); PG8_STAGE(PG8_SA(1, 1), a1 + hstep, voffA);
            PG8_WAIT_V(8); PG8_WAIT_L(0); PG8_BAR; PG8_MMA(0, 0, At, B0); PG8_MMA(0, 1, At, B1); PG8_BAR; PG8_SCHED;
            PG8_LDA(At, 0, 1); PG8_STAGE(PG8_SB(0, 0), b2, voffB); PG8_STAGE(PG8_SB(0, 1), b2 + hstep, voffB); PG8_STAGE(PG8_SA(0, 0), a2, voffA);
            PG8_WAIT_V(8); PG8_WAIT_L(0); PG8_BAR; PG8_MMA(1, 0, At, B0); PG8_MMA(1, 1, At, B1); PG8_BAR; PG8_SCHED;
            PG8_LDB(B0, 1, 0); PG8_LDB(B1, 1, 1); PG8_SCHED; PG8_LDA(At, 1, 0); PG8_STAGE(PG8_SA(0, 1), a2 + hstep, voffA);
            PG8_WAIT_V(8); PG8_WAIT_L(0); PG8_BAR; PG8_MMA(0, 0, At, B0); PG8_MMA(0, 1, At, B1); PG8_BAR; PG8_SCHED;
            PG8_LDA(At, 1, 1); PG8_STAGE(PG8_SB(1, 0), b3, voffB); PG8_STAGE(PG8_SB(1, 1), b3 + hstep, voffB); PG8_STAGE(PG8_SA(1, 0), a3, voffA);
            PG8_WAIT_V(8); PG8_WAIT_L(0); PG8_BAR; PG8_MMA(1, 0, At, B0); PG8_MMA(1, 1, At, B1); PG8_BAR; PG8_SCHED;
            } else {
            PG8_LDB(B0, 0, 0); PG8_SCHED; PG8_LDA(At, 0, 0); PG8_STAGE(PG8_SA(1, 1), a1 + hstep, voffA);
            PG8_WAIT_L(8); PG8_BAR; PG8_WAIT_L(0); PG8_MMA(0, 0, At, B0); PG8_BAR; PG8_SCHED;
            PG8_LDB(B1, 0, 1); PG8_STAGE(PG8_SB(0, 0), b2, voffB);
            PG8_BAR; PG8_WAIT_L(0); PG8_MMA(0, 1, At, B1); PG8_BAR;
            PG8_LDA(At, 0, 1); PG8_STAGE(PG8_SA(0, 0), a2, voffA);
            PG8_BAR; PG8_WAIT_L(0); PG8_MMA(1, 0, At, B0); PG8_BAR; PG8_SCHED;
            PG8_STAGE(PG8_SB(0, 1), b2 + hstep, voffB);
            PG8_WAIT_V(6); PG8_BAR; PG8_MMA(1, 1, At, B1); PG8_BAR;
            PG8_LDB(B0, 1, 0); PG8_SCHED; PG8_LDA(At, 1, 0); PG8_STAGE(PG8_SA(0, 1), a2 + hstep, voffA);
            PG8_WAIT_L(8); PG8_BAR; PG8_WAIT_L(0); PG8_MMA(0, 0, At, B0); PG8_BAR; PG8_SCHED;
            PG8_LDB(B1, 1, 1); PG8_STAGE(PG8_SB(1, 0), b3, voffB);
            PG8_BAR; PG8_WAIT_L(0); PG8_MMA(0, 1, At, B1); PG8_BAR;
            PG8_LDA(At, 1, 1); PG8_STAGE(PG8_SA(1, 0), a3, voffA);
            PG8_BAR; PG8_WAIT_L(0); PG8_MMA(1, 0, At, B0); PG8_BAR; PG8_SCHED;
            PG8_STAGE(PG8_SB(1, 1), b3 + hstep, voffB);
            PG8_WAIT_V(6); PG8_BAR; PG8_MMA(1, 1, At, B1); PG8_BAR;
            }
        }
        if constexpr (ALIGN_EPI) { if (wr == 0) PG8_BAR; }
        if constexpr (!Epi::AFTER_DRAIN) { E(acc, cur, wr, wc, fr, fq); S.done(cur); }
        if (!has_next) break;
#pragma unroll
        for (int a = 0; a < 2; ++a)
#pragma unroll
            for (int b = 0; b < 2; ++b)
#pragma unroll
                for (int m = 0; m < 4; ++m)
#pragma unroll
                    for (int n = 0; n < 2; ++n) acc[a][b][m][n] = (f32x4){0.f, 0.f, 0.f, 0.f};
        cur = nxt; cA = nA; cB = nB; ++ui;
        if constexpr (ALIGN_EPI) { if (wr == 1) PG8_BAR; }
    }
    PG8_WAIT_V(0);
    if constexpr (!ALIGN_EPI) { if (wr == 0) PG8_BAR; }
    PG8_BAR;
    if constexpr (Epi::AFTER_DRAIN) { E.fused(acc, cur, wr, wc, fr, fq, lds, wid, lane); S.done(cur); }
#undef PG8_SA
#undef PG8_SB
#undef PG8_STAGE
#undef PG8_LDA
#undef PG8_LDB
#undef PG8_MMA
#undef PG8_WAIT_V
#undef PG8_WAIT_L
#undef PG8_BAR
#undef PG8_SCHED
}
}
#ifndef DUPMASK
#define DUPMASK 0
#endif

#define LAS __attribute__((address_space(3)))
typedef unsigned short bf16;
typedef unsigned v4u __attribute__((ext_vector_type(4)));
typedef unsigned v2u __attribute__((ext_vector_type(2)));
typedef float f32x4 __attribute__((ext_vector_type(4)));
typedef short bf16x8 __attribute__((ext_vector_type(8)));
typedef short s16x4 __attribute__((ext_vector_type(4)));

constexpr int DM = 2048, NB = 4, SEQ = 2048, TOK = NB * SEQ, DFF = 8192, PITCH = 16640, NLAYER = 2;
constexpr int COL_AQ = 0, COL_AKC = 1024, COL_AVC = 1280, COL_AKS = 1536, COL_AVS = 1792, COL_AKW = 2048, COL_AVW = 2304,
              COL_BQ = 2560, COL_BK = 4096, COL_BV = 5632, COL_CQ = 7168, COL_CK = 8192, COL_CV = 9216,
              COL_MA = 10240, COL_MB = 12288, COL_MC = 14336, COL_AG = 16384;
constexpr int IN_W = 16408, GMP = 6400;
__device__ __forceinline__ size_t hmo(int b, int hidx) { return ((size_t)(b * 80 + hidx) * 2048) << 7; }
static_assert(PITCH == pg8::IP_PITCH, "pitch");

constexpr size_t MiB = 1u << 20;
constexpr size_t WS_QCTR = 32768;
constexpr size_t WS_CTL = 65536;
constexpr size_t WS_BIAS = 0;
constexpr size_t WS_ROPE = 1 * MiB;
constexpr size_t WS_BIASP = WS_ROPE + 512 * 1024;
constexpr size_t WS_WIN = 2 * MiB;
constexpr size_t WS_WMI = WS_WIN + 130 * MiB;
constexpr size_t WS_WMO = WS_WMI + 64 * MiB;
constexpr size_t WS_WO = WS_WMO + 64 * MiB;
constexpr size_t WS_WBA = WS_WO + 16 * MiB;
constexpr size_t WS_WBB = WS_WBA + 8 * MiB;
constexpr size_t WS_WBC = WS_WBB + 4 * MiB;
constexpr size_t WS_W1T = WS_WBC + 8 * MiB;
constexpr size_t WS_W2T = WS_W1T + 8 * MiB;
constexpr size_t WS_H = WS_W2T + 1 * MiB;
constexpr size_t WS_P = WS_H + 32 * MiB;
constexpr size_t WS_GM = WS_P + 160 * MiB;
constexpr size_t WS_QR = WS_P + 260 * MiB;
constexpr size_t WS_KC = WS_QR + 16 * MiB;
constexpr size_t WS_VC = WS_KC + 1 * MiB;
constexpr size_t WS_KMEAN = WS_VC + 1 * MiB;
constexpr size_t WS_SELM = WS_KMEAN + 1 * MiB;
constexpr size_t WS_OA = WS_SELM + 1 * MiB;
constexpr size_t WS_OC = WS_OA + 16 * MiB;
constexpr size_t WS_OG = WS_OC + 16 * MiB;
constexpr size_t WS_LSE = WS_OG + 24 * MiB;
constexpr size_t WS_OB = WS_LSE + 1 * MiB;
constexpr size_t WS_TMP = WS_OB + 8 * MiB;
constexpr size_t WS_MG = WS_TMP + 64 * MiB;
constexpr size_t WS_X1 = WS_MG + 32 * MiB;
constexpr size_t WS_X2 = WS_X1 + 64 * MiB;
constexpr size_t WS_U = WS_P;
constexpr size_t WS_SSP = WS_X2 + 64 * MiB;
constexpr size_t WS_END = WS_SSP + 5 * MiB;

constexpr int LDS_BYTES = 147456;

__device__ __forceinline__ unsigned f2bf(float f) { unsigned u = __builtin_bit_cast(unsigned, f); return (u + 0x7fffu + ((u >> 16) & 1u)) >> 16; }
__device__ __forceinline__ unsigned pk2(float lo, float hi) { return f2bf(lo) | (f2bf(hi) << 16); }
__device__ __forceinline__ float bf2f(bf16 b) { return __uint_as_float(((unsigned)b) << 16); }
__device__ __forceinline__ float sigm(float x) { return 1.0f / (1.0f + __expf(-x)); }
__device__ __forceinline__ float wave_sum(float v) {
#pragma unroll
    for (int o = 1; o < 64; o <<= 1) v += __shfl_xor(v, o);
    return v;
}
__device__ __forceinline__ int ltid() { int t = threadIdx.x; asm volatile("" : "+v"(t)); return t; }
__device__ __forceinline__ int lbid() { int t = blockIdx.x; asm volatile("" : "+s"(t)); return t; }
#define LDS_WAIT() asm volatile("s_waitcnt lgkmcnt(0)" ::: "memory")

struct Ctx {
    const float* in[17]; float* out; unsigned char* ws;
};

template <bool FRAG = false>
__device__ __forceinline__ void tr_item(const float* W, int K, int Nsrc, int src_n0, int nvalid, bf16* WT, int dst_row0, int k0, LAS float* scr, int lane, const float* gvec = nullptr, int dK = 0) {
    if (dK == 0) dK = K;
    {
        const int kr = lane >> 4, c4 = lane & 15;
        f32x4 v[16];
        const float* wp = W + (size_t)(k0 + kr) * Nsrc + src_n0 + 4 * c4;
#pragma unroll
        for (int i = 0; i < 16; ++i) v[i] = (4 * c4 < nvalid) ? *(const f32x4*)(wp + (size_t)(4 * i) * Nsrc) : (f32x4){0.f, 0.f, 0.f, 0.f};
#pragma unroll
        for (int i = 0; i < 16; ++i) { const float gk = gvec ? gvec[k0 + 4 * i + kr] : 1.0f; LAS float* sp = scr + (4 * i + kr) * 65 + 4 * c4; sp[0] = v[i][0] * gk; sp[1] = v[i][1] * gk; sp[2] = v[i][2] * gk; sp[3] = v[i][3] * gk; }
    }
    LDS_WAIT(); asm volatile("" ::: "memory");
    const int c = lane & 7;
#pragma unroll
    for (int j = 0; j < 8; ++j) {
        const int n = (lane >> 3) + 8 * j; const LAS float* s = scr + (8 * c) * 65 + n;
        v4u o; o.x = pk2(s[0 * 65], s[1 * 65]); o.y = pk2(s[2 * 65], s[3 * 65]); o.z = pk2(s[4 * 65], s[5 * 65]); o.w = pk2(s[6 * 65], s[7 * 65]);
        if (FRAG) {
            const int f = dst_row0 + n, k8 = (k0 >> 3) + c;
            *(v4u*)(WT + ((size_t)(((k8 >> 2) * 16 + (f >> 4)) * 64 + (k8 & 3) * 16 + (f & 15)) << 3)) = o;
        } else if (n < nvalid) *(v4u*)(WT + (size_t)(dst_row0 + n) * dK + k0 + 8 * c) = o;
    }
    LDS_WAIT(); asm volatile("" ::: "memory");
}
template <bool FRAG = false>
__device__ __forceinline__ bool tr_mat(int& r, const float* W, int K, int N, bf16* WT, LAS float* scr, int lane, const float* gvec = nullptr, int dK = 0) {
    const int nblk = N / 64, items = (K / 64) * nblk;
    if (r < items) { const int kb = r / nblk, nb = r % nblk; tr_item<FRAG>(W, K, N, nb * 64, 64, WT, nb * 64, kb * 64, scr, lane, gvec, dK); return true; }
    r -= items; return false;
}
__device__ __forceinline__ void phase_prep(const Ctx& C, LAS unsigned char* lds, bool do_bias) {
    const int tid = ltid(), lane = tid & 63, wave = tid >> 6;
    const int gw = lbid() * 8 + wave, NGW = gridDim.x * 8;
    unsigned char* ws = C.ws;
    LAS float* scr = (LAS float*)(lds + wave * 16640);
    constexpr int I_IN = 32 * 257;
    constexpr int PER_LAYER = I_IN + 16 * 32 + 8 * 32 + 16 * 32 + 32 * 32 + 32 * 128 + 128 * 32 + 64 * 4 + 4 * 2 + 64 * 4 + 4 * 2;
    for (int it = gw; it < 2 * PER_LAYER; it += NGW) {
        const int l = it / PER_LAYER; int r = it % PER_LAYER;
        if (r < I_IN) {
            const int kb = r / 257, nb = r % 257; const int n0 = nb * 64;
            const int src0 = (n0 < 2560) ? n0 : (n0 < 16384 ? n0 + 24 : 2560);
            tr_item(C.in[2] + (size_t)l * DM * IN_W, DM, IN_W, src0, nb == 256 ? 24 : 64, (bf16*)(ws + WS_WIN) + (size_t)l * PITCH * DM, n0, kb * 64, scr, lane, C.in[1] + (size_t)l * DM);
            continue;
        }
        r -= I_IN;
        if (tr_mat(r, C.in[9] + (size_t)l * 1024 * DM, 1024, DM, (bf16*)(ws + WS_WBA) + (size_t)l * DM * 2560, scr, lane, nullptr, 2560)) continue;
        if (tr_mat(r, C.in[10] + (size_t)l * 512 * DM, 512, DM, (bf16*)(ws + WS_WBA) + (size_t)l * DM * 2560 + 1024, scr, lane, nullptr, 2560)) continue;
        if (tr_mat(r, C.in[11] + (size_t)l * 1024 * DM, 1024, DM, (bf16*)(ws + WS_WBA) + (size_t)l * DM * 2560 + 1536, scr, lane, nullptr, 2560)) continue;
        if (tr_mat(r, C.in[12] + (size_t)l * DM * DM, DM, DM, (bf16*)(ws + WS_WO) + (size_t)l * DM * DM, scr, lane)) continue;
        if (tr_mat(r, C.in[14] + (size_t)l * DM * DFF, DM, DFF, (bf16*)(ws + WS_WMI) + (size_t)l * DFF * DM, scr, lane, C.in[13] + (size_t)l * DM)) continue;
        if (tr_mat(r, C.in[15] + (size_t)l * DFF * DM, DFF, DM, (bf16*)(ws + WS_WMO) + (size_t)l * DM * DFF, scr, lane)) continue;
        if (tr_mat<true>(r, C.in[4] + (size_t)l * 4096 * 256, 4096, 256, (bf16*)(ws + WS_W1T) + (size_t)(l * 2 + 0) * 256 * 4096, scr, lane)) continue;
        if (tr_mat(r, C.in[5] + (size_t)l * 256 * 128, 256, 128, (bf16*)(ws + WS_W2T) + (size_t)(l * 2 + 0) * 128 * 256, scr, lane)) continue;
        if (tr_mat<true>(r, C.in[7] + (size_t)l * 4096 * 256, 4096, 256, (bf16*)(ws + WS_W1T) + (size_t)(l * 2 + 1) * 256 * 4096, scr, lane)) continue;
        tr_mat(r, C.in[8] + (size_t)l * 256 * 128, 256, 128, (bf16*)(ws + WS_W2T) + (size_t)(l * 2 + 1) * 128 * 256, scr, lane);
    }
    float* rope = (float*)(ws + WS_ROPE);
    for (int e = lbid() * 512 + tid; e < 2048 * 16; e += gridDim.x * 512) {
        const int t = e >> 4, i = e & 15;
        const float inv = powf(500000.0f, -(float)(2 * i) / 32.0f);
        const float ang = (float)t * inv;
        rope[e] = cosf(ang); rope[2048 * 16 + e] = sinf(ang);
    }
    float* bias = (float*)(ws + WS_BIASP);
    if (do_bias) for (int task = gw; task < 4 * 4 * 32; task += NGW) {
        const int kc = task & 31, fc = (task >> 5) & 3, lk = task >> 7, l = lk >> 1, kv = lk & 1;
        const float* pe = C.in[kv ? 6 : 3] + (size_t)l * 4096;
        const float* w1 = C.in[kv ? 7 : 4] + (size_t)l * 4096 * 256;
        float acc = 0.f;
#pragma unroll 8
        for (int k = kc * 128; k < kc * 128 + 128; ++k) acc += pe[k] * w1[(size_t)k * 256 + fc * 64 + lane];
        bias[(lk * 32 + kc) * 256 + fc * 64 + lane] = acc;
    }
}

__device__ __forceinline__ void phase_cast(const float* x, bf16* ob, float* ssp) {
    const int tid = ltid(), lane = tid & 63, wave = tid >> 6;
    const int gw = lbid() * 8 + wave, NGW = gridDim.x * 8;
    for (int row = gw; row < TOK; row += NGW) {
        const float* xr = x + (size_t)row * DM;
        f32x4 v[8]; float ss = 0.f;
#pragma unroll
        for (int j = 0; j < 8; ++j) { v[j] = *(const f32x4*)(xr + (64 * j + lane) * 4); ss += (v[j][0] * v[j][0] + v[j][1] * v[j][1]) + (v[j][2] * v[j][2] + v[j][3] * v[j][3]); }
        ss = wave_sum(ss);
#pragma unroll
        for (int j = 0; j < 8; ++j) { v2u w; w.x = pk2(v[j][0], v[j][1]); w.y = pk2(v[j][2], v[j][3]); *(v2u*)(ob + (size_t)row * DM + (64 * j + lane) * 4) = w; }
        if (lane < 32) ssp[(size_t)row * 32 + lane] = (lane == 0) ? ss : 0.f;
    }
}
__device__ __forceinline__ void phase_final(const float* x, const float* g, const float* ssp, float* of) {
    const int tid = ltid(), lane = tid & 63, wave = tid >> 6;
    const int gw = lbid() * 8 + wave, NGW = gridDim.x * 8;
    f32x4 gv[8];
#pragma unroll
    for (int j = 0; j < 8; ++j) gv[j] = *(const f32x4*)(g + (64 * j + lane) * 4);
    for (int row = gw; row < TOK; row += NGW) {
        const float rs = pg8::row_rscale(ssp, row);
        const float* xr = x + (size_t)row * DM;
#pragma unroll
        for (int j = 0; j < 8; ++j) { const f32x4 y = *(const f32x4*)(xr + (64 * j + lane) * 4) * rs * gv[j]; *(f32x4*)(of + (size_t)row * DM + (64 * j + lane) * 4) = y; }
    }
}
template <bool OUTF32>
__device__ __forceinline__ void phase_norm(const float* x, const float* g, bf16* ob, float* of) {
    const int tid = ltid(), lane = tid & 63, wave = tid >> 6;
    const int gw = lbid() * 8 + wave, NGW = gridDim.x * 8;
    f32x4 gv[8];
#pragma unroll
    for (int j = 0; j < 8; ++j) gv[j] = *(const f32x4*)(g + (64 * j + lane) * 4);
    for (int row = gw; row < TOK; row += NGW) {
        const float* xr = x + (size_t)row * DM;
        f32x4 v[8]; float ss = 0.f;
#pragma unroll
        for (int j = 0; j < 8; ++j) { v[j] = *(const f32x4*)(xr + (64 * j + lane) * 4); ss += (v[j][0] * v[j][0] + v[j][1] * v[j][1]) + (v[j][2] * v[j][2] + v[j][3] * v[j][3]); }
        const float rs = rsqrtf(wave_sum(ss) * (1.0f / DM) + 1e-6f);
#pragma unroll
        for (int j = 0; j < 8; ++j) {
            const f32x4 y = v[j] * rs * gv[j];
            if (OUTF32) *(f32x4*)(of + (size_t)row * DM + (64 * j + lane) * 4) = y;
            else { v2u w; w.x = pk2(y[0], y[1]); w.y = pk2(y[2], y[3]); *(v2u*)(ob + (size_t)row * DM + (64 * j + lane) * 4) = w; }
        }
    }
}

namespace att {
constexpr int KP = 288, VP = 288, KTB = 64 * KP, VTB = 64 * VP, BUFB = KTB + VTB;
constexpr int MISC = 2 * BUFB;
constexpr float SC = 0.08838834764831845f * 1.4426950408889634f;
constexpr float NEG_INF = -__builtin_inff();

struct Cfg { const bf16* K; const bf16* V; size_t kstride; int jt_lo, jt_hi, W, bshift; unsigned tor; };
typedef unsigned u32x2_t __attribute__((ext_vector_type(2)));
__device__ __forceinline__ float rows_max(float v) {
    u32x2_t r = __builtin_amdgcn_permlane32_swap(__float_as_uint(v), __float_as_uint(v), false, false);
    const float a = fmaxf(__uint_as_float(r.x), __uint_as_float(r.y));
    r = __builtin_amdgcn_permlane16_swap(__float_as_uint(a), __float_as_uint(a), false, false);
    return fmaxf(__uint_as_float(r.x), __uint_as_float(r.y));
}
__device__ __forceinline__ float rows_sum(float v) {
    u32x2_t r = __builtin_amdgcn_permlane32_swap(__float_as_uint(v), __float_as_uint(v), false, false);
    const float a = __uint_as_float(r.x) + __uint_as_float(r.y);
    r = __builtin_amdgcn_permlane16_swap(__float_as_uint(a), __float_as_uint(a), false, false);
    return __uint_as_float(r.x) + __uint_as_float(r.y);
}

__device__ __forceinline__ bool tile_on(const Cfg& c, int jt) { return c.bshift < 0 || ((c.tor >> ((jt * 64) >> c.bshift)) & 1u); }
__device__ __forceinline__ int next_tile(const Cfg& c, int jt) { while (jt <= c.jt_hi && !tile_on(c, jt)) ++jt; return jt; }

__device__ __forceinline__ void tile_gload(const Cfg& c, int jt, int tid, v4u (&kr)[2], v4u (&vr)[2]) {
#pragma unroll
    for (int i = 0; i < 2; ++i) {
        const int ch = tid + i * 512, row = ch >> 4, c16 = ch & 15;
        const size_t off = (size_t)(jt * 64 + row) * c.kstride + c16 * 8;
        kr[i] = *(const v4u*)(c.K + off); vr[i] = *(const v4u*)(c.V + off);
    }
}
__device__ __forceinline__ void tile_lwrite(LAS unsigned char* buf, int tid, const v4u (&kr)[2], const v4u (&vr)[2]) {
#pragma unroll
    for (int i = 0; i < 2; ++i) {
        const int ch = tid + i * 512, row = ch >> 4, c16 = ch & 15;
        *(LAS v4u*)(buf + row * KP + c16 * 16) = kr[i];
        *(LAS v4u*)(buf + KTB + row * VP + c16 * 16) = vr[i];
    }
}
__device__ __forceinline__ s16x4 vtr(const LAS unsigned char* p) { return __builtin_bit_cast(s16x4, __builtin_amdgcn_ds_read_tr16_b64_v4i16((LAS s16x4*)p)); }
__device__ __forceinline__ bf16x8 pack8(const f32x4& a, const f32x4& b) {
    v4u w; w.x = pg8::cvt_pk_bf16(a[0], a[1]); w.y = pg8::cvt_pk_bf16(a[2], a[3]); w.z = pg8::cvt_pk_bf16(b[0], b[1]); w.w = pg8::cvt_pk_bf16(b[2], b[3]);
    return __builtin_bit_cast(bf16x8, w);
}
template <int NT>
__device__ __forceinline__ void pv_chunk(const LAS unsigned char* vt, int cc, int li, int q4, const bf16x8 (&pf)[NT], f32x4 (&o)[NT][8]) {
    const LAS unsigned char* vp = vt + (cc * 32 + 4 * q4 + (li >> 2)) * VP + (4 * (li & 3)) * 2;
#pragma unroll
    for (int dg = 0; dg < 2; ++dg) {
        s16x4 v0[4], v1[4];
        asm volatile("s_waitcnt lgkmcnt(0)" ::: "memory");
#pragma unroll
        for (int d = 0; d < 4; ++d) { v0[d] = vtr(vp + (dg * 4 + d) * 32); v1[d] = vtr(vp + (dg * 4 + d) * 32 + 16 * VP); }
        __builtin_amdgcn_sched_barrier(0);
#pragma unroll
        for (int d = 0; d < 4; ++d) {
            bf16x8 vf; vf[0] = v0[d][0]; vf[1] = v0[d][1]; vf[2] = v0[d][2]; vf[3] = v0[d][3]; vf[4] = v1[d][0]; vf[5] = v1[d][1]; vf[6] = v1[d][2]; vf[7] = v1[d][3];
#pragma unroll
            for (int nt = 0; nt < NT; ++nt) o[nt][dg * 4 + d] = __builtin_amdgcn_mfma_f32_16x16x32_bf16(vf, pf[nt], o[nt][dg * 4 + d], 0, 0, 0);
        }
        __builtin_amdgcn_sched_barrier(0);
    }
}

template <int NT>
__device__ __forceinline__ void tile_compute(const LAS unsigned char* buf, const Cfg& c, int jt, int lane, const bf16x8 (&qf)[NT][4], const int (&qpos)[NT], const unsigned (&bits)[NT],
                                             f32x4 (&o)[NT][8], float (&m)[NT], float (&l)[NT], int qmin) {
    const int li = lane & 15, q4 = lane >> 4;
    const int k0 = jt * 64, qmax = qmin + 16 * NT - 1;
    bool anyrow = true, allrow = true;
    if (c.bshift >= 0) {
        bool hit = false, all = true;
#pragma unroll
        for (int nt = 0; nt < NT; ++nt) { const bool b = (bits[nt] >> (k0 >> c.bshift)) & 1u; hit = hit || b; all = all && b; }
        anyrow = __builtin_amdgcn_ballot_w64(hit) != 0ull; allrow = __builtin_amdgcn_ballot_w64(!all) == 0ull;
    }
    if (!(k0 <= qmax && qmin - (k0 + 63) < c.W && anyrow)) return;
    const bool full = allrow && (k0 + 63 <= qmin) && (qmax - k0 < c.W);
    f32x4 s[NT][4];
#pragma unroll
    for (int nt = 0; nt < NT; ++nt)
#pragma unroll
        for (int kb = 0; kb < 4; ++kb) s[nt][kb] = (f32x4){0.f, 0.f, 0.f, 0.f};
    const LAS unsigned char* kp = buf + li * KP + q4 * 16;
#pragma unroll
    for (int ks = 0; ks < 4; ++ks)
#pragma unroll
        for (int kb = 0; kb < 4; ++kb) {
            const bf16x8 kf = *(const LAS bf16x8*)(kp + kb * 16 * KP + ks * 64);
#pragma unroll
            for (int nt = 0; nt < NT; ++nt) s[nt][kb] = __builtin_amdgcn_mfma_f32_16x16x32_bf16(kf, qf[nt][ks], s[nt][kb], 0, 0, 0);
        }
    bf16x8 pf[2][NT];
#pragma unroll
    for (int nt = 0; nt < NT; ++nt) {
        float mx = NEG_INF;
        if (full) {
#pragma unroll
            for (int kb = 0; kb < 4; ++kb) mx = fmaxf(mx, fmaxf(fmaxf(s[nt][kb][0], s[nt][kb][1]), fmaxf(s[nt][kb][2], s[nt][kb][3])));
        } else {
            const int hi = qpos[nt] - (jt * 64 + q4 * 4);
            unsigned wrow = (unsigned)c.W;
            if (c.bshift >= 0) wrow = ((bits[nt] >> ((jt * 64) >> c.bshift)) & 1u) ? wrow : 0u;
#pragma unroll
            for (int kb = 0; kb < 4; ++kb)
#pragma unroll
                for (int jj = 0; jj < 4; ++jj) {
                    const bool ok = (unsigned)(hi - (kb * 16 + jj)) < wrow;
                    const float x = ok ? s[nt][kb][jj] : NEG_INF;
                    s[nt][kb][jj] = x; mx = fmaxf(mx, x);
                }
        }
        mx = rows_max(mx);
        const float mn = fmaxf(m[nt], mx), alpha = __builtin_amdgcn_exp2f((m[nt] - mn) * SC);
        m[nt] = mn;
        const float nms = -mn * SC;
        float rs = 0.f;
#pragma unroll
        for (int kb = 0; kb < 4; ++kb)
#pragma unroll
            for (int jj = 0; jj < 4; ++jj) { const float p = __builtin_amdgcn_exp2f(__builtin_fmaf(s[nt][kb][jj], SC, nms)); s[nt][kb][jj] = p; rs += p; }
        rs = rows_sum(rs);
        l[nt] = l[nt] * alpha + rs;
        if (__builtin_amdgcn_ballot_w64(alpha != 1.0f) != 0ull) {
#pragma unroll
            for (int db = 0; db < 8; ++db) o[nt][db] = o[nt][db] * alpha;
        }
        pf[0][nt] = pack8(s[nt][0], s[nt][1]); pf[1][nt] = pack8(s[nt][2], s[nt][3]);
    }
    const LAS unsigned char* vt = buf + KTB;
    pv_chunk<NT>(vt, 0, li, q4, pf[0], o);
    pv_chunk<NT>(vt, 1, li, q4, pf[1], o);
}

template <int NT>
__device__ __forceinline__ void run_attn(LAS unsigned char* lds, const Cfg& c, const bf16* qbase, const unsigned (&qoff)[NT], const int (&qpos)[NT], const unsigned (&bits)[NT],
                                         bf16* dbase, const unsigned (&doff)[NT], const float (&gate)[NT], bool accum, float* lsebase) {
    const int tid = ltid(), lane = tid & 63, li = lane & 15, q4 = lane >> 4;
    bf16x8 qf[NT][4];
#pragma unroll
    for (int nt = 0; nt < NT; ++nt)
#pragma unroll
        for (int ks = 0; ks < 4; ++ks) qf[nt][ks] = *(const bf16x8*)(qbase + (size_t)qoff[nt] + ks * 32 + q4 * 8);
    f32x4 o[NT][8]; float m[NT], l[NT];
#pragma unroll
    for (int nt = 0; nt < NT; ++nt) {
        m[nt] = -1e30f; l[nt] = 0.f;
#pragma unroll
        for (int db = 0; db < 8; ++db) o[nt][db] = (f32x4){0.f, 0.f, 0.f, 0.f};
    }
    const int qmin = __builtin_amdgcn_readfirstlane(qpos[0]);
    __syncthreads();
#define ATT_BAR() do { asm volatile("s_waitcnt lgkmcnt(0)" ::: "memory"); __builtin_amdgcn_s_barrier(); asm volatile("" ::: "memory"); } while (0)
    int jt = next_tile(c, c.jt_lo);
    if (jt <= c.jt_hi) {
        v4u ka[2], va[2], kb[2], vb[2];
        tile_gload(c, jt, tid, ka, va);
        tile_lwrite(lds, tid, ka, va);
        int jn = next_tile(c, jt + 1);
        if (jn <= c.jt_hi) tile_gload(c, jn, tid, ka, va);
        ATT_BAR();
        int bsel = 0;
        for (;;) {
            int jn2 = (jn <= c.jt_hi) ? next_tile(c, jn + 1) : jn;
            if (jn2 <= c.jt_hi) tile_gload(c, jn2, tid, kb, vb);
            tile_compute<NT>(lds + bsel * BUFB, c, jt, lane, qf, qpos, bits, o, m, l, qmin);
            if (jn <= c.jt_hi) tile_lwrite(lds + (bsel ^ 1) * BUFB, tid, ka, va);
            ATT_BAR();
            if (jn > c.jt_hi) break;
            jt = jn; jn = jn2; bsel ^= 1;
            jn2 = (jn <= c.jt_hi) ? next_tile(c, jn + 1) : jn;
            if (jn2 <= c.jt_hi) tile_gload(c, jn2, tid, ka, va);
            tile_compute<NT>(lds + bsel * BUFB, c, jt, lane, qf, qpos, bits, o, m, l, qmin);
            if (jn <= c.jt_hi) tile_lwrite(lds + (bsel ^ 1) * BUFB, tid, kb, vb);
            ATT_BAR();
            if (jn > c.jt_hi) break;
            jt = jn; jn = jn2; bsel ^= 1;
        }
    }
#undef ATT_BAR
#pragma unroll
    for (int nt = 0; nt < NT; ++nt) {
        const float sc = gate[nt] / fmaxf(l[nt], 1e-30f);
        bf16* dp = dbase + (size_t)doff[nt] + q4 * 4;
#pragma unroll
        for (int db = 0; db < 8; ++db) {
            f32x4 v = o[nt][db] * sc;
            if (accum) { const unsigned long long ow = __hip_atomic_load((const unsigned long long*)(dp + db * 16), __ATOMIC_RELAXED, __HIP_MEMORY_SCOPE_AGENT); v2u old; old.x = (unsigned)ow; old.y = (unsigned)(ow >> 32); v[0] += pg8::bf_lo(old.x); v[1] += pg8::bf_hi(old.x); v[2] += pg8::bf_lo(old.y); v[3] += pg8::bf_hi(old.y); }
            v2u w; w.x = pg8::cvt_pk_bf16(v[0], v[1]); w.y = pg8::cvt_pk_bf16(v[2], v[3]);
            *(v2u*)(dp + db * 16) = w;
        }
        if (lsebase != nullptr && q4 == 0) lsebase[doff[nt] >> 7] = (m[nt] * SC + log2f(fmaxf(l[nt], 1e-30f))) * 0.6931471805599453f;
    }
}
}

struct Bufs {
    bf16 *P, *GM, *QR, *KC, *VC, *OA, *OC, *OG, *OB; float *KMEAN, *LSE; unsigned* SELM;
};

template <int NT>
__device__ __forceinline__ void unit_dilated(LAS unsigned char* lds, const Bufs& B, int gi, int r, int b, int hh, int cls, int i0) {
    const int tid = ltid(), lane = tid & 63, wave = tid >> 6, li = lane & 15;
    constexpr int ROWS = NT * 128;
    const int head = gi * 4 + hh;
    att::Cfg c;
    c.K = B.P + hmo(b, 32 + head) + cls * 128; c.V = B.P + hmo(b, 44 + head) + cls * 128; c.kstride = (size_t)r * 128;
    c.jt_lo = (i0 >= 128) ? ((i0 - 128) >> 6) : 0; c.jt_hi = (i0 + ROWS - 1) >> 6; c.W = 129; c.bshift = -1; c.tor = 0u;
    unsigned qoff[NT]; int qpos[NT]; unsigned bits[NT]; unsigned doff[NT]; float gate[NT];
#pragma unroll
    for (int nt = 0; nt < NT; ++nt) {
        const int i = i0 + NT * 16 * wave + 16 * nt + li, tok = cls + r * i;
        qoff[nt] = (unsigned)tok * 128u; qpos[nt] = i; bits[nt] = 0u;
        doff[nt] = (unsigned)(gi * TOK + b * SEQ + tok) * 512u + hh * 128; gate[nt] = 1.0f;
    }
    att::run_attn<NT>(lds, c, B.P + hmo(b, 20 + head), qoff, qpos, bits, B.OG, doff, gate, false, B.LSE);
}

__device__ __forceinline__ void unit_cmp(LAS unsigned char* lds, const Bufs& B, int uidx) {
    using namespace att;
    const int tid = ltid(), lane = tid & 63, wave = tid >> 6, li = lane & 15, q4 = lane >> 4;
    const int q_blk = uidx & 31, g = (uidx >> 5) & 1, b = uidx >> 6;
    __syncthreads();
    {
        const bf16* Kc = B.KC + (size_t)((b * 2 + g) * 128) * 128; const bf16* Vc = B.VC + (size_t)((b * 2 + g) * 128) * 128;
#pragma unroll
        for (int i = 0; i < 4; ++i) {
            const int ch = tid + i * 512, row = ch >> 4, c16 = ch & 15, bf = row >> 6, rr = row & 63;
            const v4u kv = *(const v4u*)(Kc + row * 128 + c16 * 8), vv = *(const v4u*)(Vc + row * 128 + c16 * 8);
            *(LAS v4u*)(lds + bf * BUFB + rr * KP + c16 * 16) = kv;
            *(LAS v4u*)(lds + bf * BUFB + KTB + rr * VP + c16 * 16) = vv;
        }
    }
    int tt[2], hh[2]; bf16x8 qf[2][4];
#pragma unroll
    for (int nt = 0; nt < 2; ++nt) {
        const int R = 32 * wave + 16 * nt + li; tt[nt] = 64 * q_blk + (R >> 2); hh[nt] = g * 4 + (R & 3);
        const bf16* qp = B.P + hmo(b, hh[nt]) + tt[nt] * 128 + q4 * 8;
#pragma unroll
        for (int ks = 0; ks < 4; ++ks) qf[nt][ks] = *(const bf16x8*)(qp + ks * 32);
    }
    __syncthreads();
    f32x4 s[2][8];
#pragma unroll
    for (int nt = 0; nt < 2; ++nt)
#pragma unroll
        for (int kb = 0; kb < 8; ++kb) s[nt][kb] = (f32x4){0.f, 0.f, 0.f, 0.f};
#pragma unroll
    for (int bf = 0; bf < 2; ++bf) {
        const LAS unsigned char* kp = lds + bf * BUFB + li * KP + q4 * 16;
#pragma unroll
        for (int ks = 0; ks < 4; ++ks)
#pragma unroll
            for (int kb = 0; kb < 4; ++kb) {
                const bf16x8 kf = *(const LAS bf16x8*)(kp + kb * 16 * KP + ks * 64);
#pragma unroll
                for (int nt = 0; nt < 2; ++nt) s[nt][bf * 4 + kb] = __builtin_amdgcn_mfma_f32_16x16x32_bf16(kf, qf[nt][ks], s[nt][bf * 4 + kb], 0, 0, 0);
            }
    }
    LAS float* impbuf = (LAS float*)(lds + MISC);
    bf16x8 pf[4][2];
#pragma unroll
    for (int nt = 0; nt < 2; ++nt) {
        const int qpos = (tt[nt] >= 31) ? ((tt[nt] - 31) >> 4) : -1;
        float mx = NEG_INF;
#pragma unroll
        for (int kb = 0; kb < 8; ++kb)
#pragma unroll
            for (int jj = 0; jj < 4; ++jj) { const int j = kb * 16 + q4 * 4 + jj; const float x = (j <= qpos) ? s[nt][kb][jj] * SC : NEG_INF; s[nt][kb][jj] = x; mx = fmaxf(mx, x); }
        mx = fmaxf(mx, __shfl_xor(mx, 16)); mx = fmaxf(mx, __shfl_xor(mx, 32)); mx = fmaxf(mx, -1e30f);
        float rs = 0.f;
#pragma unroll
        for (int kb = 0; kb < 8; ++kb)
#pragma unroll
            for (int jj = 0; jj < 4; ++jj) { const float p = __builtin_amdgcn_exp2f(s[nt][kb][jj] - mx); s[nt][kb][jj] = p; rs += p; }
        rs += __shfl_xor(rs, 16); rs += __shfl_xor(rs, 32);
        const float inv = 1.0f / fmaxf(rs, 1e-30f);
        float xprev = 0.f;
#pragma unroll
        for (int kb = 0; kb < 8; ++kb) {
            s[nt][kb] = s[nt][kb] * inv;
            const float own = (s[nt][kb][0] + s[nt][kb][1]) + (s[nt][kb][2] + 0.5f * s[nt][kb][3]);
            const float x3 = 0.5f * s[nt][kb][3];
            const float snd = (q4 == 3) ? xprev : x3;
            const float rcv = __shfl(snd, (lane + 48) & 63);
            xprev = x3;
            float tot = own + rcv;
            tot += __shfl_xor(tot, 1); tot += __shfl_xor(tot, 2);
            if ((li & 3) == 0) impbuf[(8 * wave + 4 * nt + (li >> 2)) * 32 + kb * 4 + q4] = tot;
        }
#pragma unroll
        for (int c = 0; c < 4; ++c) pf[c][nt] = pack8(s[nt][2 * c], s[nt][2 * c + 1]);
    }
    f32x4 o[2][8];
#pragma unroll
    for (int nt = 0; nt < 2; ++nt)
#pragma unroll
        for (int db = 0; db < 8; ++db) o[nt][db] = (f32x4){0.f, 0.f, 0.f, 0.f};
#pragma unroll
    for (int c = 0; c < 4; ++c) pv_chunk<2>(lds + (c >> 1) * BUFB + KTB, c & 1, li, q4, pf[c], o);
#pragma unroll
    for (int nt = 0; nt < 2; ++nt) {
        const size_t rowg = (size_t)(b * SEQ + tt[nt]);
        const float gate = sigm(bf2f(B.GM[rowg * GMP + 6144 + hh[nt] * 3 + 0]));
        bf16* dp = B.OA + rowg * 2560 + hh[nt] * 128 + q4 * 4;
#pragma unroll
        for (int db = 0; db < 8; ++db) { const f32x4 v = o[nt][db] * gate; v2u w; w.x = pg8::cvt_pk_bf16(v[0], v[1]); w.y = pg8::cvt_pk_bf16(v[2], v[3]); *(v2u*)(dp + db * 16) = w; }
    }
    __syncthreads();
#pragma unroll 1
    for (int i = 0; i < 4; ++i) {
        const int idx = tid + i * 512, tl = idx >> 5, j = idx & 31;
        bool sel;
        if (j > q_blk) sel = false;
        else if (q_blk < 16) sel = true;
        else if (j == 0 || j >= q_blk - 1) sel = true;
        else {
            const float me = impbuf[tl * 32 + j]; int rank = 0;
            for (int jp = 1; jp <= q_blk - 2; ++jp) { const float ov = impbuf[tl * 32 + jp]; rank += ((ov > me) || (ov == me && jp < j)) ? 1 : 0; }
            sel = rank < 13;
        }
        const unsigned long long bal = __ballot(sel);
        if ((lane & 31) == 0) B.SELM[(size_t)(b * SEQ + 64 * q_blk + tl) * 2 + g] = (lane < 32) ? (unsigned)bal : (unsigned)(bal >> 32);
    }
}

__device__ __forceinline__ void unit_nsa(LAS unsigned char* lds, const Bufs& B, int uidx) {
    const int tid = ltid(), lane = tid & 63, wave = tid >> 6, li = lane & 15;
    const int q_blk = uidx & 31, g = (uidx >> 5) & 1, b = uidx >> 6;
    unsigned qoff[2], doff[2]; int qpos[2]; unsigned bits[2]; float gate[2]; int gcol[2];
    unsigned ob = 0u;
#pragma unroll
    for (int nt = 0; nt < 2; ++nt) {
        const int R = 32 * wave + 16 * nt + li, rr = R >> 6, t = 64 * q_blk + (R & 63), h = g * 4 + rr;
        qoff[nt] = (unsigned)((b * 8 + h) * SEQ + t) * 128u; doff[nt] = (unsigned)(b * SEQ + t) * 2560u + h * 128; qpos[nt] = t;
        bits[nt] = __hip_atomic_load(B.SELM + (size_t)(b * SEQ + t) * 2 + g, __ATOMIC_RELAXED, __HIP_MEMORY_SCOPE_AGENT); ob |= bits[nt];
        gcol[nt] = 6144 + h * 3;
    }
#pragma unroll
    for (int o = 1; o < 64; o <<= 1) ob |= __shfl_xor(ob, o);
    LAS unsigned* orw = (LAS unsigned*)(lds + att::MISC);
    __syncthreads();
    if (tid == 0) orw[0] = 0u;
    __syncthreads();
    if (lane == 0) __hip_atomic_fetch_or(orw, ob, __ATOMIC_RELAXED, __HIP_MEMORY_SCOPE_WORKGROUP);
    __syncthreads();
    const unsigned tor = orw[0];
#pragma unroll 1
    for (int pass = 0; pass < 2; ++pass) {
        att::Cfg c;
        c.K = B.P + hmo(b, (pass == 0 ? 12 : 16) + g); c.V = B.P + hmo(b, (pass == 0 ? 14 : 18) + g); c.kstride = 128;
        c.jt_lo = (pass == 0) ? 0 : (q_blk >= 8 ? q_blk - 8 : 0); c.jt_hi = q_blk;
        c.W = (pass == 0) ? (1 << 30) : 512; c.bshift = (pass == 0) ? 6 : -1; c.tor = tor;
#pragma unroll
        for (int nt = 0; nt < 2; ++nt) gate[nt] = sigm(bf2f(B.GM[(size_t)(b * SEQ + qpos[nt]) * GMP + gcol[nt] + 1 + pass]));
        att::run_attn<2>(lds, c, B.QR, qoff, qpos, bits, B.OA, doff, gate, true, nullptr);
    }
}

__device__ __forceinline__ void unit_moba(LAS unsigned char* lds, const Bufs& B, int b, int h, int qb) {
    const int tid = ltid(), lane = tid & 63, wave = tid >> 6, li = lane & 15;
    LAS unsigned* mb = (LAS unsigned*)(lds + att::MISC);
    __syncthreads();
    if (tid == 0) mb[256] = 0u;
    {
        const int row = tid >> 1, half = tid & 1, t = 256 * qb + row;
        const bf16* qp = B.P + hmo(b, 56 + h) + t * 128 + half * 64;
        LAS float* kml = (LAS float*)(lds + att::MISC + 2048);
        if (tid < 224) *(LAS f32x4*)(kml + tid * 4) = *(const f32x4*)(B.KMEAN + (size_t)((b * 8 + h) * 8) * 128 + tid * 4);
        __syncthreads();
        const LAS float* km = kml + half * 64;
        float acc[7];
#pragma unroll
        for (int j = 0; j < 7; ++j) acc[j] = 0.f;
#pragma unroll 2
        for (int ch = 0; ch < 8; ++ch) {
            const v4u qw = *(const v4u*)(qp + ch * 8);
            float q[8]; q[0] = pg8::bf_lo(qw.x); q[1] = pg8::bf_hi(qw.x); q[2] = pg8::bf_lo(qw.y); q[3] = pg8::bf_hi(qw.y); q[4] = pg8::bf_lo(qw.z); q[5] = pg8::bf_hi(qw.z); q[6] = pg8::bf_lo(qw.w); q[7] = pg8::bf_hi(qw.w);
#pragma unroll
            for (int j = 0; j < 7; ++j) if (j < qb) {
                const f32x4 k0 = *(const LAS f32x4*)(km + j * 128 + ch * 8), k1 = *(const LAS f32x4*)(km + j * 128 + ch * 8 + 4);
                acc[j] += (q[0] * k0[0] + q[1] * k0[1]) + (q[2] * k0[2] + q[3] * k0[3]) + (q[4] * k1[0] + q[5] * k1[1]) + (q[6] * k1[2] + q[7] * k1[3]);
            }
        }
        unsigned bt = 0u;
#pragma unroll
        for (int j = 0; j < 7; ++j) acc[j] += __shfl_xor(acc[j], 1);
        if (qb <= 3) bt = (1u << qb) - 1u;
        else {
#pragma unroll
            for (int j = 0; j < 7; ++j) if (j < qb) {
                int rank = 0;
#pragma unroll
                for (int jp = 0; jp < 7; ++jp) if (jp < qb && jp != j) rank += ((acc[jp] > acc[j]) || (acc[jp] == acc[j] && jp < j)) ? 1 : 0;
                if (rank < 3) bt |= 1u << j;
            }
        }
        bt |= 1u << qb;
        if (half == 0) mb[row] = bt;
        unsigned ob = bt;
#pragma unroll
        for (int o = 1; o < 64; o <<= 1) ob |= __shfl_xor(ob, o);
        __syncthreads();
        if (lane == 0) __hip_atomic_fetch_or(mb + 256, ob, __ATOMIC_RELAXED, __HIP_MEMORY_SCOPE_WORKGROUP);
        __syncthreads();
    }
    att::Cfg c;
    c.K = B.P + hmo(b, 64 + h); c.V = B.P + hmo(b, 72 + h); c.kstride = 128; c.jt_lo = 0; c.jt_hi = 4 * qb + 3; c.W = 1 << 30; c.bshift = 8; c.tor = mb[256];
    unsigned qoff[2]; int qpos[2]; unsigned bits[2]; unsigned doff[2]; float gate[2];
#pragma unroll
    for (int nt = 0; nt < 2; ++nt) {
        const int R = 32 * wave + 16 * nt + li, t = 256 * qb + R;
        qoff[nt] = (unsigned)t * 128u; qpos[nt] = t; bits[nt] = mb[R];
        doff[nt] = (unsigned)(b * SEQ + t) * 2560u + h * 128; gate[nt] = 1.0f;
    }
    att::run_attn<2>(lds, c, B.P + hmo(b, 56 + h), qoff, qpos, bits, B.OC, doff, gate, false, nullptr);
}

__device__ __forceinline__ float gelu_tanh(float x) {
    const float u = 0.7978845608028654f * (x + 0.044715f * x * x * x);
    const float e = __expf(2.0f * u);
    const float th = 1.0f - 2.0f / (e + 1.0f);
    return 0.5f * x * (1.0f + th);
}
__device__ __forceinline__ void unit_compress(LAS unsigned char* lds, const Bufs& B, const bf16* W1T, const bf16* W2T, const float* bias, int kv, int rt) {
    const int tid = ltid(), lane = tid & 63, wave = tid >> 6, li = lane & 15, q4 = lane >> 4;
    LAS float* hacc = (LAS float*)lds;
    LAS unsigned char* hb = lds + 131072;
    LAS float* bsum = (LAS float*)(lds + 131072 + 8448);
    __syncthreads();
    if (tid < 256) { float bs = 0.f;
#pragma unroll 8
        for (int kc = 0; kc < 32; ++kc) bs += bias[kc * 256 + tid];
        bsum[tid] = bs; }
    const int rho0 = rt * 32 + li, bg = rho0 >> 7, b = bg >> 1, g = bg & 1;
    const bf16* abase = B.P + hmo(b, (kv ? 10 : 8) + g);
    f32x4 acc[2][16];
#pragma unroll
    for (int tl = 0; tl < 2; ++tl)
#pragma unroll
        for (int nb = 0; nb < 16; ++nb) acc[tl][nb] = (f32x4){0.f, 0.f, 0.f, 0.f};
#pragma unroll 1
    for (int ll = 0; ll < 4; ++ll) {
        const int l = 4 * wave + ll;
        int tok0 = 16 * (rho0 & 127) + l, tok1 = tok0 + 256; tok0 = tok0 > SEQ - 1 ? SEQ - 1 : tok0; tok1 = tok1 > SEQ - 1 ? SEQ - 1 : tok1;
        const bf16* ap0 = abase + tok0 * 128 + q4 * 8;
        const bf16* ap1 = abase + tok1 * 128 + q4 * 8;
        const bf16* bp = W1T + ((size_t)(l * 4) * 16 * 64 + lane) * 8;
#pragma unroll
        for (int ds = 0; ds < 4; ++ds) {
            const bf16x8 af0 = *(const bf16x8*)(ap0 + ds * 32), af1 = *(const bf16x8*)(ap1 + ds * 32);
#pragma unroll
            for (int nb = 0; nb < 16; ++nb) {
                const bf16x8 bfr = *(const bf16x8*)(bp + (size_t)((ds * 16 + nb) * 64) * 8);
                acc[0][nb] = __builtin_amdgcn_mfma_f32_16x16x32_bf16(af0, bfr, acc[0][nb], 0, 0, 0);
                acc[1][nb] = __builtin_amdgcn_mfma_f32_16x16x32_bf16(af1, bfr, acc[1][nb], 0, 0, 0);
            }
        }
    }
    bf16* outp = (kv ? B.VC : B.KC);
#pragma unroll
    for (int tl = 0; tl < 2; ++tl) {
#pragma unroll
        for (int nb = 0; nb < 16; ++nb)
#pragma unroll
            for (int jj = 0; jj < 4; ++jj) hacc[wave * 4096 + (4 * q4 + jj) * 256 + nb * 16 + li] = acc[tl][nb][jj];
        __syncthreads();
        for (int e = tid; e < 4096; e += 512) {
            const int row = e >> 8, f = e & 255;
            float hs = 0.f;
#pragma unroll
            for (int w = 0; w < 8; ++w) hs += hacc[w * 4096 + e];
            const float v = gelu_tanh(hs + bsum[f]);
            *(LAS bf16*)(hb + row * 528 + f * 2) = (bf16)f2bf(v);
        }
        __syncthreads();
        f32x4 o2 = (f32x4){0.f, 0.f, 0.f, 0.f};
#pragma unroll
        for (int ks = 0; ks < 8; ++ks) {
            const bf16x8 af = *(const LAS bf16x8*)(hb + li * 528 + (ks * 32 + q4 * 8) * 2);
            const bf16x8 bfr = *(const bf16x8*)(W2T + (size_t)(wave * 16 + li) * 256 + ks * 32 + q4 * 8);
            o2 = __builtin_amdgcn_mfma_f32_16x16x32_bf16(af, bfr, o2, 0, 0, 0);
        }
#pragma unroll
        for (int jj = 0; jj < 4; ++jj) outp[(size_t)(rt * 32 + tl * 16 + 4 * q4 + jj) * 128 + wave * 16 + li] = (bf16)f2bf(o2[jj]);
        __syncthreads();
    }
}
__device__ __forceinline__ void gate_gemm(const Bufs& B, const bf16* H, const bf16* Wg, const float* ssp, int gwv, int nwv) {
    const int lane = ltid() & 63, li = lane & 15, q4 = lane >> 4;
    for (int rt = gwv; rt < TOK / 16; rt += nwv) {
        const bf16* ap = H + (size_t)(rt * 16 + li) * DM + q4 * 8;
        const bf16* bp = Wg + (size_t)li * DM + q4 * 8;
        f32x4 a0 = (f32x4){0.f, 0.f, 0.f, 0.f}, a1 = a0;
#pragma unroll 8
        for (int ks = 0; ks < DM / 32; ++ks) {
            const bf16x8 af = *(const bf16x8*)(ap + ks * 32);
            const bf16x8 b0 = *(const bf16x8*)(bp + ks * 32), b1 = *(const bf16x8*)(bp + (size_t)16 * DM + ks * 32);
            a0 = __builtin_amdgcn_mfma_f32_16x16x32_bf16(af, b0, a0, 0, 0, 0);
            a1 = __builtin_amdgcn_mfma_f32_16x16x32_bf16(af, b1, a1, 0, 0, 0);
        }
#pragma unroll
        for (int jj = 0; jj < 4; ++jj) {
            bf16* op = B.GM + (size_t)(rt * 16 + 4 * q4 + jj) * GMP + 6144 + li;
            const float rs = pg8::row_rscale(ssp, rt * 16 + 4 * q4 + jj);
            op[0] = (bf16)f2bf(a0[jj] * rs); op[16] = (bf16)f2bf(a1[jj] * rs);
        }
    }
}
__device__ __forceinline__ void unit_kmean(LAS unsigned char* lds, const Bufs& B, int item) {
    const int tid = ltid();
    const int j = item & 7, h = (item >> 3) & 7, b = item >> 6;
    LAS float* red = (LAS float*)lds;
    __syncthreads();
    const int d8 = tid & 15, tg = tid >> 4;
    float a[8];
#pragma unroll
    for (int e = 0; e < 8; ++e) a[e] = 0.f;
#pragma unroll
    for (int i = 0; i < 8; ++i) {
        const int t = 256 * j + tg + 32 * i;
        const v4u w = *(const v4u*)(B.P + hmo(b, 64 + h) + t * 128 + d8 * 8);
        a[0] += pg8::bf_lo(w.x); a[1] += pg8::bf_hi(w.x); a[2] += pg8::bf_lo(w.y); a[3] += pg8::bf_hi(w.y); a[4] += pg8::bf_lo(w.z); a[5] += pg8::bf_hi(w.z); a[6] += pg8::bf_lo(w.w); a[7] += pg8::bf_hi(w.w);
    }
#pragma unroll
    for (int e = 0; e < 8; ++e) red[tg * 128 + d8 * 8 + e] = a[e];
    __syncthreads();
    if (tid < 128) {
        float s = 0.f;
#pragma unroll 8
        for (int i = 0; i < 32; ++i) s += red[i * 128 + tid];
        B.KMEAN[(size_t)item * 128 + tid] = s * (1.0f / 256.0f);
    }
}
__device__ __forceinline__ void phase_dilmerge(const Bufs& B) {
    const int tid = ltid(), lane = tid & 63, wave = tid >> 6;
    const int gw = lbid() * 8 + wave, NGW = gridDim.x * 8;
    const int slot = lane >> 4, d8 = lane & 15;
    for (int row = gw; row < TOK; row += NGW) {
        float ls[3];
#pragma unroll
        for (int g = 0; g < 3; ++g) ls[g] = B.LSE[((size_t)g * TOK + row) * 4 + slot];
        const float mx = fmaxf(ls[0], fmaxf(ls[1], ls[2]));
        float w[3]; float sw = 0.f;
#pragma unroll
        for (int g = 0; g < 3; ++g) { w[g] = __expf(ls[g] - mx); sw += w[g]; }
        const float inv = 1.0f / sw;
        float a[8];
#pragma unroll
        for (int e = 0; e < 8; ++e) a[e] = 0.f;
#pragma unroll
        for (int g = 0; g < 3; ++g) {
            const v4u v = *(const v4u*)(B.OG + ((size_t)g * TOK + row) * 512 + slot * 128 + d8 * 8); const float ww = w[g] * inv;
            a[0] += ww * pg8::bf_lo(v.x); a[1] += ww * pg8::bf_hi(v.x); a[2] += ww * pg8::bf_lo(v.y); a[3] += ww * pg8::bf_hi(v.y);
            a[4] += ww * pg8::bf_lo(v.z); a[5] += ww * pg8::bf_hi(v.z); a[6] += ww * pg8::bf_lo(v.w); a[7] += ww * pg8::bf_hi(v.w);
        }
        v4u o; o.x = pk2(a[0], a[1]); o.y = pk2(a[2], a[3]); o.z = pk2(a[4], a[5]); o.w = pk2(a[6], a[7]);
        *(v4u*)(B.OB + (size_t)row * 2560 + slot * 128 + d8 * 8) = o;
    }
}

#define RLX_AGENT __ATOMIC_RELAXED, __HIP_MEMORY_SCOPE_AGENT
#define XB_TMO      128
#define XB_XCNT(j)  (256  + 64 * (j))
#define XB_XSUB(j)  (1280 + 64 * (j))
#define XB_XGEN(j)  (2304 + 64 * (j))
#define XB_TOP      3328
#define XB_TOPGEN   3392
#define XCD_BAR_WORDS 3456
#define XB_SPIN_CAP (1u << 18)

__device__ __forceinline__ unsigned xb_ld(unsigned* p)              { return __hip_atomic_load(p, __ATOMIC_RELAXED, __HIP_MEMORY_SCOPE_AGENT); }
__device__ __forceinline__ unsigned xb_add(unsigned* p, unsigned v) { return __hip_atomic_fetch_add(p, v, __ATOMIC_RELAXED, __HIP_MEMORY_SCOPE_AGENT); }
__device__ __forceinline__ unsigned xb_xcc_id() { return (unsigned)__builtin_amdgcn_s_getreg((3 << 11) | 20) & 0xFu; }
#define XB_SPIN(cond, bar) do { unsigned _sp = 0; while (cond) { __builtin_amdgcn_s_sleep(1); \
    if ((++_sp & 255u) == 0u) { if (xb_ld(&(bar)[XB_TMO])) break; if (_sp > XB_SPIN_CAP) { atomicAdd(&(bar)[XB_TMO], 1u); break; } } } } while (0)

struct XcdBarrier {
    unsigned* bar; unsigned x;
    volatile LAS unsigned* st;
};

__device__ __forceinline__ XcdBarrier xcd_barrier_post(unsigned* bar, volatile LAS unsigned* st) {
    XcdBarrier b; b.bar = bar; b.x = xb_xcc_id(); b.st = st;
    if (threadIdx.x == 0) (void)xb_add(&bar[XB_XCNT(b.x)], 1u);
    return b;
}
__device__ __forceinline__ void xcd_barrier_complete(unsigned* bar, unsigned x, unsigned& nloc, unsigned& nx) {
    const unsigned G = gridDim.x * gridDim.y * gridDim.z;
    unsigned sum, cnt, mine, sp = 0u;
    for (;;) {
        sum = 0u; cnt = 0u; mine = 0u;
#pragma unroll
        for (unsigned j = 0; j < 16; ++j) { const unsigned c = xb_ld(&bar[XB_XCNT(j)]); sum += c; cnt += (c > 0u) ? 1u : 0u; mine = (j == x) ? c : mine; }
        if (sum == G) break;
        __builtin_amdgcn_s_sleep(1);
        if ((++sp & 255u) == 0u) { if (xb_ld(&bar[XB_TMO])) break; if (sp > XB_SPIN_CAP) { atomicAdd(&bar[XB_TMO], 1u); break; } }
    }
    nloc = mine > 0u ? mine : 1u; nx = cnt > 0u ? cnt : 1u;
}

__device__ __forceinline__ void xcd_barrier(const XcdBarrier& b) {
    asm volatile("s_waitcnt vmcnt(0)" ::: "memory");
    __syncthreads();
    if (threadIdx.x == 0) {
        unsigned* bar = b.bar;
        __builtin_amdgcn_s_waitcnt(0);
        unsigned nloc = b.st[0], nx = b.st[1];
        if (nloc == 0u) { xcd_barrier_complete(bar, b.x, nloc, nx); b.st[0] = nloc; b.st[1] = nx; }
        const unsigned old = xb_add(&bar[XB_XSUB(b.x)], 1u);
        const unsigned gen = old / nloc;
        if (old + 1u == (gen + 1u) * nloc) {
            __builtin_amdgcn_fence(__ATOMIC_RELEASE, "agent");
            asm volatile("s_waitcnt vmcnt(0)" ::: "memory");
            const unsigned og = xb_add(&bar[XB_TOP], 1u);
            const unsigned tg = og / nx;
            if (og + 1u == (tg + 1u) * nx) xb_add(&bar[XB_TOPGEN], 1u);
            else XB_SPIN(xb_ld(&bar[XB_TOPGEN]) == tg, bar);
            __builtin_amdgcn_fence(__ATOMIC_ACQUIRE, "agent");
            xb_add(&bar[XB_XGEN(b.x)], 1u);
            asm volatile("s_waitcnt vmcnt(0)" ::: "memory");
        } else {
            XB_SPIN(xb_ld(&bar[XB_XGEN(b.x)]) == gen, bar);
            __builtin_amdgcn_fence(__ATOMIC_ACQUIRE, "agent");
            asm volatile("s_waitcnt vmcnt(0)" ::: "memory");
        }
    }
    __syncthreads();
}

__device__ __forceinline__ void panel_rscale(LAS float* rst, const float* ssp, int pm) {
    const int tid = ltid(), row = tid >> 1, half = tid & 1;
    const f32x4* pp = (const f32x4*)(ssp + (size_t)(pm * 256 + row) * 32 + half * 16);
    float sacc = 0.f;
#pragma unroll
    for (int i = 0; i < 4; ++i) { const f32x4 v = pp[i]; sacc += (v[0] + v[1]) + (v[2] + v[3]); }
    sacc += __shfl_xor(sacc, 1);
    if (half == 0) rst[row] = rsqrtf(sacc * (1.0f / 2048.0f) + 1e-6f);
    __syncthreads();
}
struct Args { const float* in[17]; float* out; unsigned char* ws; int lo, hi, coop, pad; };
constexpr int NPHASE = 22;

typedef const __attribute__((address_space(4))) Args* KArgs;
__device__ __forceinline__ KArgs kargs() { KArgs p = (KArgs)__builtin_amdgcn_kernarg_segment_ptr(); asm volatile("" : "+s"(p)); return p; }
__device__ __forceinline__ Bufs mk_bufs(unsigned char* ws) {
    Bufs B;
    B.P = (bf16*)(ws + WS_P); B.GM = (bf16*)(ws + WS_GM); B.QR = (bf16*)(ws + WS_QR); B.KC = (bf16*)(ws + WS_KC); B.VC = (bf16*)(ws + WS_VC);
    B.OA = (bf16*)(ws + WS_TMP); B.OC = B.OA + 1536; B.OG = (bf16*)(ws + WS_OG); B.OB = B.OA + 1024;
    B.KMEAN = (float*)(ws + WS_KMEAN); B.LSE = (float*)(ws + WS_LSE); B.SELM = (unsigned*)(ws + WS_SELM);
    return B;
}
__global__ void __launch_bounds__(512, 2) mk_fwd(Args args_unused) {
    extern __shared__ __attribute__((aligned(16))) unsigned char lds_raw[];
    LAS unsigned char* lds = (LAS unsigned char*)lds_raw;
    cg::grid_group grid = cg::this_grid();
    const int lo = kargs()->lo, hi = kargs()->hi, coop = kargs()->coop;
    volatile LAS unsigned* xst = (volatile LAS unsigned*)(lds + LDS_BYTES - 64);
    if (threadIdx.x < 4) xst[threadIdx.x] = 0u;
    __syncthreads();
    XcdBarrier xbar; xbar.bar = (unsigned*)(kargs()->ws + WS_CTL); xbar.x = 0; xbar.st = nullptr;
    if (coop) xbar = xcd_barrier_post((unsigned*)(kargs()->ws + WS_CTL), xst);
    const int G = gridDim.x;
#define IN(k) (lo <= (k) && (k) < hi)
#define SEAM(k) do { if (coop && (k) + 1 < hi) { if (hi > NPHASE) grid.sync(); else xcd_barrier(xbar); } } while (0)

    if (IN(0)) {
        KArgs ka = kargs(); const int bid = lbid(); (void)bid; Ctx C;
#pragma unroll
        for (int i = 0; i < 17; ++i) C.in[i] = ka->in[i];
        C.out = ka->out; C.ws = ka->ws;
        for (int rep_ = 0; rep_ < 1 + (DUPMASK & 1); ++rep_) phase_prep(C, lds, rep_ == 0);
        phase_cast(C.in[0], (bf16*)(C.ws + WS_H), (float*)(C.ws + WS_SSP));
        SEAM(0);
    }

#pragma unroll 1
    for (int l = 0; l < NLAYER; ++l) {
        const int pb = 1 + 10 * l;
        if (IN(pb + 1)) {
          for (int rep_ = 0; rep_ < 1 + ((DUPMASK >> 2) & 1); ++rep_) {
            KArgs ka = kargs(); const int bid = lbid(); (void)bid; unsigned char* ws = ka->ws;
            pg8::Gemm g{(const bf16*)(ws + WS_H), (const bf16*)(ws + WS_WIN) + (size_t)l * PITCH * DM, TOK, 16384, DM}; pg8::StaticOrder S; S.init(TOK, 16384, G, bid);
            const float* ssp_ = (const float*)(ws + WS_SSP) + (size_t)(2 * l) * TOK * 32;
            LAS float* rst = (LAS float*)(lds + 131072 + 1024);
            pg8::Unit u0; const int pm0 = S.next(0, u0) ? u0.pm : 0;
            panel_rscale(rst, ssp_, pm0);
            pg8::EpiInProj E{(bf16*)(ws + WS_P), (bf16*)(ws + WS_QR), (bf16*)(ws + WS_GM), (const float*)(ws + WS_ROPE), rst};
            pg8::gemm_phase<pg8::EpiInProj, pg8::StaticOrder, true, true>(lds, g, S, E);
            }
            SEAM(pb + 1);
        }
        if (IN(pb + 2)) {
          for (int rep_ = 0; rep_ < 1 + ((DUPMASK >> 3) & 1); ++rep_) {
            KArgs ka = kargs(); const int bid = lbid(); (void)bid; unsigned char* ws = ka->ws; const Bufs B = mk_bufs(ws);
            for (int task = bid; task < 64; task += G) {
                const int kv = task & 1, rt = task >> 1;
                unit_compress(lds, B, (const bf16*)(ws + WS_W1T) + (size_t)(l * 2 + kv) * 256 * 4096, (const bf16*)(ws + WS_W2T) + (size_t)(l * 2 + kv) * 128 * 256,
                              (const float*)(ws + WS_BIASP) + (size_t)(l * 2 + kv) * 32 * 256, kv, rt);
            }
            for (int item = (bid + 128) % G; item < 256; item += G) unit_kmean(lds, B, item);
            {
                const int wv = ltid() >> 6, gwv = ((bid + G / 2) % G) * 8 + wv;
                gate_gemm(B, (const bf16*)(ws + WS_H), (const bf16*)(ws + WS_WIN) + (size_t)l * PITCH * DM + (size_t)16384 * DM, (const float*)(ws + WS_SSP) + (size_t)(2 * l) * TOK * 32, gwv, G * 8);
            }
            {
                unsigned* qc = (unsigned*)(ws + WS_QCTR) + 64 * l;
                LAS unsigned* qs = (LAS unsigned*)(lds + LDS_BYTES - 32);
                for (;;) {
                    __syncthreads();
                    if (ltid() == 0) qs[0] = __hip_atomic_fetch_add(qc, 1u, __ATOMIC_RELAXED, __HIP_MEMORY_SCOPE_AGENT);
                    __syncthreads();
                    const int u = (int)qs[0];
                    if (u >= 512) break;
                    if (u < 128) unit_dilated<2>(lds, B, 0, 1, u >> 5, (u >> 3) & 3, 0, (u & 7) * 256);
                    else if (u < 256) { const int v = u - 128; unit_dilated<2>(lds, B, 1, 4, v >> 5, (v >> 3) & 3, (v >> 1) & 3, (v & 1) * 256); }
                    else { const int v = u - 256; unit_dilated<1>(lds, B, 2, 16, v >> 6, (v >> 4) & 3, v & 15, 0); }
                }
            }
            }
            SEAM(pb + 2);
        }
        if (IN(pb + 4)) {
          for (int rep_ = 0; rep_ < 1 + ((DUPMASK >> 5) & 1); ++rep_) {
            { KArgs ka = kargs(); const int bid = lbid(); (void)bid; const Bufs B = mk_bufs(ka->ws);
              for (int u = bid; u < 256; u += G) unit_cmp(lds, B, u); }
            asm volatile("s_waitcnt vmcnt(0)" ::: "memory"); __syncthreads();
            { KArgs ka = kargs(); const int bid = lbid(); (void)bid; const Bufs B = mk_bufs(ka->ws);
              for (int u = bid; u < 256; u += G) unit_nsa(lds, B, u); }
            for (int rep2_ = 0; rep2_ < 1 + ((DUPMASK >> 12) & 1); ++rep2_)
            { KArgs ka = kargs(); const int bid = lbid(); (void)bid; const Bufs B = mk_bufs(ka->ws);
              for (int u = bid; u < 256; u += G) { const int q_blk = u & 31, g = (u >> 5) & 1, b = u >> 6; unit_moba(lds, B, b, (q_blk & 3) * 2 + g, 7 - (q_blk >> 2)); } }
            { KArgs ka = kargs(); const int bid = lbid(); (void)bid; const Bufs B = mk_bufs(ka->ws); phase_dilmerge(B); }
            }
            SEAM(pb + 4);
        }
        if (IN(pb + 5)) {
          for (int rep_ = 0; rep_ < 1 + ((DUPMASK >> 6) & 1); ++rep_) {
            { KArgs ka = kargs(); const int bid = lbid(); unsigned char* ws = ka->ws;
              pg8::StaticOrder S; S.init(TOK, DM, G, bid);
              pg8::Gemm g{(const bf16*)(ws + WS_TMP), (const bf16*)(ws + WS_WBA) + (size_t)l * DM * 2560, TOK, DM, 2560};
              pg8::EpiBranchF E{(const bf16*)(ws + WS_GM), (bf16*)(ws + WS_MG)};
              pg8::gemm_phase<pg8::EpiBranchF, pg8::StaticOrder, true, true>(lds, g, S, E); }
            }
            SEAM(pb + 5);
        }
        if (IN(pb + 6)) {
          for (int rep_ = 0; rep_ < 1 + ((DUPMASK >> 7) & 1); ++rep_) {
            KArgs ka = kargs(); const int bid = lbid(); (void)bid; unsigned char* ws = ka->ws;
            const float* xin = (l == 0) ? ka->in[0] : (const float*)(ws + WS_X2);
            pg8::Gemm g{(const bf16*)(ws + WS_MG), (const bf16*)(ws + WS_WO) + (size_t)l * DM * DM, TOK, DM, DM}; pg8::StaticOrder S; S.init(TOK, DM, G, bid);
            pg8::EpiResid E{xin, (float*)(ws + WS_X1), (bf16*)(ws + WS_H), (float*)(ws + WS_SSP) + (size_t)(2 * l + 1) * TOK * 32};
            pg8::gemm_phase<pg8::EpiResid, pg8::StaticOrder, true, true>(lds, g, S, E);
            }
            SEAM(pb + 6);
        }
        if (IN(pb + 8)) {
          for (int rep_ = 0; rep_ < 1 + ((DUPMASK >> 9) & 1); ++rep_) {
            KArgs ka = kargs(); const int bid = lbid(); (void)bid; unsigned char* ws = ka->ws;
            pg8::Gemm g{(const bf16*)(ws + WS_H), (const bf16*)(ws + WS_WMI) + (size_t)l * DFF * DM, TOK, DFF, DM}; pg8::StaticOrder S; S.init(TOK, DFF, G, bid);
            const float* ssp_ = (const float*)(ws + WS_SSP) + (size_t)(2 * l + 1) * TOK * 32;
            LAS float* rst = (LAS float*)(lds + 131072 + 1024);
            pg8::Unit u0; const int pm0 = S.next(0, u0) ? u0.pm : 0;
            panel_rscale(rst, ssp_, pm0);
            pg8::EpiRelu2 E{(bf16*)(ws + WS_U), rst};
            pg8::gemm_phase<pg8::EpiRelu2, pg8::StaticOrder, true, true>(lds, g, S, E);
            }
            SEAM(pb + 8);
        }
        if (IN(pb + 9)) {
          for (int rep_ = 0; rep_ < 1 + ((DUPMASK >> 10) & 1); ++rep_) {
            KArgs ka = kargs(); const int bid = lbid(); (void)bid; unsigned char* ws = ka->ws;
            pg8::Gemm g{(const bf16*)(ws + WS_U), (const bf16*)(ws + WS_WMO) + (size_t)l * DM * DFF, TOK, DM, DFF}; pg8::StaticOrder S; S.init(TOK, DM, G, bid);
            pg8::EpiResid E{(const float*)(ws + WS_X1), (float*)(ws + WS_X2), (bf16*)(ws + WS_H), (float*)(ws + WS_SSP) + (size_t)(2 * l + 2) * TOK * 32};
            pg8::gemm_phase<pg8::EpiResid, pg8::StaticOrder, true, true>(lds, g, S, E);
            }
            SEAM(pb + 9);
        }
    }
    if (IN(21)) { KArgs ka = kargs(); const int bid = lbid(); (void)bid; phase_final((const float*)(ka->ws + WS_X2), ka->in[16], (const float*)(ka->ws + WS_SSP) + (size_t)4 * TOK * 32, ka->out); }
#undef IN
#undef SEAM
}

#ifndef DUPMASK
#define DUPMASK 0
#endif
#ifndef MK_RUN_PHASES
#define MK_RUN_PHASES NPHASE
#endif
#ifndef MK_MULTI
#define MK_MULTI 0
#endif
extern "C" void kernel_launch(void* const* d_in, const int* in_sizes, int n_in, void* d_out, int out_size, void* d_ws, size_t ws_size, hipStream_t stream) {
    static int grid = 0;
    if (grid == 0) {
        if (n_in != 17 || out_size != TOK * DM || ws_size < WS_END) { fprintf(stderr, "kernel_launch: unexpected shapes (n_in %d out %d ws %zu need %zu)\n", n_in, out_size, ws_size, (size_t)WS_END); grid = -1; return; }
        int dev = 0, cus = 0, per_cu = 0;
        hipGetDevice(&dev); hipDeviceGetAttribute(&cus, hipDeviceAttributeMultiprocessorCount, dev);
        if (hipFuncSetAttribute((const void*)mk_fwd, hipFuncAttributeMaxDynamicSharedMemorySize, LDS_BYTES) != hipSuccess) { fprintf(stderr, "kernel_launch: hipFuncSetAttribute failed\n"); grid = -1; return; }
        hipOccupancyMaxActiveBlocksPerMultiprocessor(&per_cu, (const void*)mk_fwd, 512, LDS_BYTES);
        (void)hipGetLastError();
        if (per_cu < 1) per_cu = 1;
        grid = cus * 1;
        if (grid != 256) { fprintf(stderr, "kernel_launch: this kernel assumes a 256-CU device (got %d)\n", cus); grid = 256; }
    }
    if (grid < 0) return;
    hipMemsetAsync((char*)d_ws, 0, 131072, stream);
    Args a{};
    for (int i = 0; i < 17; ++i) a.in[i] = (const float*)d_in[i];
    a.out = (float*)d_out; a.ws = (unsigned char*)d_ws;
#if MK_MULTI
    for (int p = 0; p < MK_RUN_PHASES; ++p) {
        a.lo = p; a.hi = p + 1; a.coop = 0;
        hipLaunchKernelGGL(mk_fwd, dim3(grid), dim3(512), LDS_BYTES, stream, a);
    }
#else
    a.lo = 0; a.hi = NPHASE; a.coop = 1;
    void* kargs[] = {&a};
    hipError_t e = hipLaunchCooperativeKernel((const void*)mk_fwd, dim3(grid), dim3(512), kargs, LDS_BYTES, stream);
    if (e != hipSuccess) fprintf(stderr, "cooperative launch failed: %s (grid %d)\n", hipGetErrorString(e), grid);
#endif
}
```
